# Optimizing an MI355X kernel written in HIP

```python
import jax, jax.numpy as jnp
from jax import lax
import numpy as np

D_MODEL = 1024
BATCH = 4
SEQ = 4096
DEPTH = 4

CHUNK = 64
HEAD_DIM = 64
A_HEADS = 8
A_WIDTH = A_HEADS * HEAD_DIM
A_LEFT_CHUNKS = 8
A_BAND = (A_LEFT_CHUNKS + 1) * CHUNK
REL_CLIP = 256
POOL_WINDOWS = (2, 4, 8, 16)
POOL_GROUPS = 4
POOL_GROUP_DIM = 128
B_WIDTH = POOL_GROUPS * POOL_GROUP_DIM
C_HEADS = 4
C_QK_WIDTH = C_HEADS * 2 * HEAD_DIM
C_V_DIM = 2 * HEAD_DIM
C_WIDTH = C_HEADS * C_V_DIM
Q_BLOCK = 128
ROPE_THETA = 500000.0
ROPE_DIM = HEAD_DIM // 4
N_BRANCH = 3
IN_SIZES = [A_WIDTH] * 3 + [B_WIDTH] + [C_QK_WIDTH] * 2 + [C_WIDTH] + [D_MODEL] * N_BRANCH
D_IN = sum(IN_SIZES)
N_EXPERTS = 64
TOP_K = 8
N_GROUPS = 8
TOPK_GROUPS = 4
EXPERT_DIM = 256
ROUTED_SCALE = 2.5
DISPATCH_BLOCK = 128
DN_ALPHA = (2 * DEPTH) ** 0.25
DN_BETA = (8 * DEPTH) ** -0.25
LN_EPS = 1e-5
RMS_EPS = 1e-5

kernel_name = "hybrid_chunk_causal_moe_trunk"


def layer_norm(x, g, b):
    x32 = x.astype(jnp.float32)
    mu = jnp.mean(x32, axis=-1, keepdims=True)
    var = jnp.mean(jnp.square(x32 - mu), axis=-1, keepdims=True)
    return ((x32 - mu) * lax.rsqrt(var + LN_EPS)).astype(x.dtype) * g + b


def rope_tables(seq, dtype):
    inv = ROPE_THETA ** (-jnp.arange(0, ROPE_DIM, 2, dtype=jnp.float32) / ROPE_DIM)
    ang = jnp.arange(seq, dtype=jnp.float32)[:, None] * inv[None, :]
    return jnp.cos(ang).astype(dtype), jnp.sin(ang).astype(dtype)


def apply_partial_rope(x, cos, sin):
    half = ROPE_DIM // 2
    x1, x2, rest = x[..., :half], x[..., half:ROPE_DIM], x[..., ROPE_DIM:]
    c = cos[:, None, None, :]
    s = sin[:, None, None, :]
    return jnp.concatenate([x1 * c - x2 * s, x2 * c + x1 * s, rest], axis=-1)


def chunked_relpos_attention(q, k, v, rel_bias):
    B, S = q.shape[:2]
    nc = S // CHUNK
    shp = (B, nc, CHUNK, A_HEADS, HEAD_DIM)
    qc = q.reshape(shp)
    pad = ((0, 0), (A_LEFT_CHUNKS, 0), (0, 0), (0, 0), (0, 0))
    kp = jnp.pad(k.reshape(shp), pad)
    vp = jnp.pad(v.reshape(shp), pad)
    band_shape = (B, nc, A_BAND, A_HEADS, HEAD_DIM)
    kb = jnp.stack([kp[:, j:j + nc] for j in range(A_LEFT_CHUNKS + 1)], axis=2).reshape(band_shape)
    vb = jnp.stack([vp[:, j:j + nc] for j in range(A_LEFT_CHUNKS + 1)], axis=2).reshape(band_shape)
    s = jnp.einsum('bcqhd,bckhd->bhcqk', qc, kb).astype(jnp.float32) * (HEAD_DIM ** -0.5)
    qpos = A_LEFT_CHUNKS * CHUNK + jnp.arange(CHUNK)
    kpos = jnp.arange(A_BAND)
    rel = jnp.clip(qpos[:, None] - kpos[None, :], -REL_CLIP, REL_CLIP) + REL_CLIP
    bias = rel_bias[:, rel].astype(jnp.float32)
    valid = (jnp.arange(nc)[:, None] + kpos[None, :] // CHUNK) >= A_LEFT_CHUNKS
    s = jnp.where(valid[None, None, :, None, :], s + bias[None, :, None], -jnp.inf)
    p = jax.nn.softmax(s, axis=-1).astype(v.dtype)
    o = jnp.einsum('bhcqk,bckhd->bcqhd', p, vb)
    return o.reshape(B, S, A_WIDTH)


def multiscale_pool_mixer(u, pool_w, pool_scale):
    B, S, _ = u.shape
    ug = u.reshape(B, S, POOL_GROUPS, POOL_GROUP_DIM).astype(jnp.float32)
    csp = jnp.pad(jnp.cumsum(ug, axis=1), ((0, 0), (1, 0), (0, 0), (0, 0)))
    t = jnp.arange(S)
    pooled = []
    for g, w in enumerate(POOL_WINDOWS):
        hi = csp[:, 1:, g]
        lo = jnp.pad(csp[:, :S + 1 - w, g], ((0, 0), (w - 1, 0), (0, 0)))
        cnt = jnp.minimum(t + 1, w).astype(jnp.float32)[None, :, None]
        pooled.append((hi - lo) / cnt)
    mixed = (jnp.stack(pooled, axis=2) - ug).astype(u.dtype)
    y = jnp.einsum('bsgc,gcd->bsgd', mixed, pool_w).reshape(B, S, B_WIDTH)
    return y * pool_scale


def differential_attention(q, k, v, lam, lambda_init, subln_g, cos, sin):
    B, S = q.shape[:2]
    q = apply_partial_rope(q, cos, sin) * (HEAD_DIM ** -0.5)
    k = apply_partial_rope(k, cos, sin)
    nqb = S // Q_BLOCK
    qb = jnp.moveaxis(q.reshape(B, nqb, Q_BLOCK, C_HEADS, 2, HEAD_DIM), 1, 0)
    k_chunk = jnp.arange(S) // CHUNK

    def one_block(args):
        qblk, i = args
        s = jnp.einsum('bqhcd,bkhcd->bhcqk', qblk, k).astype(jnp.float32)
        q_chunk = (i * Q_BLOCK + jnp.arange(Q_BLOCK)) // CHUNK
        mask = k_chunk[None, :] <= q_chunk[:, None]
        p = jax.nn.softmax(jnp.where(mask, s, -jnp.inf), axis=-1)
        attn = (p[:, :, 0] - lam * p[:, :, 1]).astype(v.dtype)
        return jnp.einsum('bhqk,bkhe->bqhe', attn, v)

    o = lax.map(one_block, (qb, jnp.arange(nqb)))
    o = jnp.moveaxis(o, 0, 1).reshape(B, S, C_HEADS, C_V_DIM)
    o32 = o.astype(jnp.float32)
    o = (o32 * lax.rsqrt(jnp.mean(o32 * o32, axis=-1, keepdims=True) + RMS_EPS)).astype(v.dtype) * subln_g
    return (o * (1.0 - lambda_init)).reshape(B, S, C_WIDTH)


def hybrid_mixer(x, layer_idx, w_in, rel_bias, pool_w, pool_scale, lambda_q1, lambda_k1,
                 lambda_q2, lambda_k2, subln_g, w_branch_a, w_branch_b, w_branch_c, w_out, cos, sin):
    B, S, _ = x.shape
    z = x @ w_in
    bounds = [int(v) for v in np.cumsum(IN_SIZES)[:-1]]
    qa, ka, va, ub, qc, kc, vc, ga, gb, gc = jnp.split(z, bounds, axis=-1)
    a_shape = (B, S, A_HEADS, HEAD_DIM)
    ya = chunked_relpos_attention(qa.reshape(a_shape), ka.reshape(a_shape), va.reshape(a_shape), rel_bias)
    yb = multiscale_pool_mixer(ub, pool_w, pool_scale)
    lambda_init = 0.8 - 0.6 * float(np.exp(-0.3 * layer_idx))
    lam = (jnp.exp(jnp.sum(lambda_q1.astype(jnp.float32) * lambda_k1.astype(jnp.float32)))
           - jnp.exp(jnp.sum(lambda_q2.astype(jnp.float32) * lambda_k2.astype(jnp.float32)))
           + lambda_init)
    c_shape = (B, S, C_HEADS, 2, HEAD_DIM)
    yc = differential_attention(qc.reshape(c_shape), kc.reshape(c_shape),
                                vc.reshape(B, S, C_HEADS, C_V_DIM), lam, lambda_init, subln_g, cos, sin)
    merged = (jax.nn.sigmoid(ga) * (ya @ w_branch_a)
              + jax.nn.sigmoid(gb) * (yb @ w_branch_b)
              + jax.nn.sigmoid(gc) * (yc @ w_branch_c))
    return merged @ w_out


def route(x_flat, router_w, router_bias):
    n = x_flat.shape[0]
    scores = jax.nn.sigmoid((x_flat @ router_w).astype(jnp.float32))
    choice = scores + router_bias.astype(jnp.float32)
    grp = choice.reshape(n, N_GROUPS, N_EXPERTS // N_GROUPS)
    grp_score = jnp.sum(lax.top_k(grp, 2)[0], axis=-1)
    _, top_groups = lax.top_k(grp_score, TOPK_GROUPS)
    gmask = jnp.sum(jax.nn.one_hot(top_groups, N_GROUPS), axis=1) > 0
    emask = jnp.repeat(gmask, N_EXPERTS // N_GROUPS, axis=1)
    _, idx = lax.top_k(jnp.where(emask, choice, -jnp.inf), TOP_K)
    w = jnp.take_along_axis(scores, idx, axis=-1)
    w = w / jnp.sum(w, axis=-1, keepdims=True) * ROUTED_SCALE
    return idx, w.astype(x_flat.dtype)


def routed_experts(x_flat, idx, wts, w_gate_up, w_down):
    n, d = x_flat.shape
    nk = n * TOP_K
    e = idx.reshape(nk)
    tok = jnp.arange(nk, dtype=jnp.int32) // TOP_K
    gate = wts.reshape(nk)
    order = jnp.argsort(e)
    e_s, tok_s, gate_s = e[order], tok[order], gate[order]
    counts = jnp.zeros((N_EXPERTS,), jnp.int32).at[e].add(1)
    padded = (counts + DISPATCH_BLOCK - 1) // DISPATCH_BLOCK * DISPATCH_BLOCK
    start = jnp.cumsum(counts) - counts
    pend = jnp.cumsum(padded)
    pstart = pend - padded
    dest = pstart[e_s] + (jnp.arange(nk, dtype=jnp.int32) - start[e_s])
    nb = (nk + DISPATCH_BLOCK - 1) // DISPATCH_BLOCK + N_EXPERTS
    rows = nb * DISPATCH_BLOCK
    row_tok = jnp.full((rows,), n, jnp.int32).at[dest].set(tok_s)
    row_gate = jnp.zeros((rows,), gate.dtype).at[dest].set(gate_s)
    blk_expert = jnp.minimum(
        jnp.searchsorted(pend, jnp.arange(nb, dtype=jnp.int32) * DISPATCH_BLOCK, side='right'),
        N_EXPERTS - 1)
    x_pad = jnp.concatenate([x_flat, jnp.zeros((1, d), x_flat.dtype)], axis=0)

    def one_block(args):
        t, g, ex = args
        h = x_pad[t] @ w_gate_up[ex]
        h = jax.nn.silu(h[:, :EXPERT_DIM]) * h[:, EXPERT_DIM:]
        return (h @ w_down[ex]) * g[:, None]

    y = lax.map(one_block, (row_tok.reshape(nb, DISPATCH_BLOCK),
                            row_gate.reshape(nb, DISPATCH_BLOCK), blk_expert))
    out = jnp.zeros((n + 1, d), y.dtype).at[row_tok].add(y.reshape(rows, d))
    return out[:n]


def shared_expert(x_flat, w_gate_up, w_down):
    h = x_flat @ w_gate_up
    return (jax.nn.silu(h[:, :EXPERT_DIM]) * h[:, EXPERT_DIM:]) @ w_down


def setup_inputs(seed: int = 0) -> dict:
    key = jax.random.key(seed)
    ks = jax.random.split(key, 24)
    L, D, E, F = DEPTH, D_MODEL, N_EXPERTS, EXPERT_DIM

    def nrm(k, shape, scale):
        return jax.random.normal(k, shape, jnp.float32) * scale

    return {
        "x": nrm(ks[0], (BATCH, SEQ, D), 1.0),
        "w_in": nrm(ks[1], (L, D, D_IN), D ** -0.5),
        "rel_bias": nrm(ks[2], (L, A_HEADS, 2 * REL_CLIP + 1), 0.2),
        "pool_w": nrm(ks[3], (L, POOL_GROUPS, POOL_GROUP_DIM, POOL_GROUP_DIM), POOL_GROUP_DIM ** -0.5),
        "pool_scale": 1.0 + nrm(ks[4], (L, B_WIDTH), 0.05),
        "lambda_q1": nrm(ks[5], (L, HEAD_DIM), 0.1),
        "lambda_k1": nrm(ks[6], (L, HEAD_DIM), 0.1),
        "lambda_q2": nrm(ks[7], (L, HEAD_DIM), 0.1),
        "lambda_k2": nrm(ks[8], (L, HEAD_DIM), 0.1),
        "subln_g": 1.0 + nrm(ks[9], (L, C_V_DIM), 0.05),
        "w_branch_a": nrm(ks[10], (L, A_WIDTH, D), A_WIDTH ** -0.5),
        "w_branch_b": nrm(ks[11], (L, B_WIDTH, D), B_WIDTH ** -0.5),
        "w_branch_c": nrm(ks[12], (L, C_WIDTH, D), C_WIDTH ** -0.5),
        "w_out": nrm(ks[13], (L, D, D), D ** -0.5 * DN_BETA),
        "ln1_g": 1.0 + nrm(ks[14], (L, D), 0.05),
        "ln1_b": nrm(ks[15], (L, D), 0.02),
        "router_w": nrm(ks[16], (L, D, E), D ** -0.5),
        "router_bias": nrm(ks[17], (L, E), 0.01),
        "expert_w_gate_up": nrm(ks[18], (L, E, D, 2 * F), D ** -0.5),
        "expert_w_down": nrm(ks[19], (L, E, F, D), F ** -0.5 * DN_BETA),
        "shared_w_gate_up": nrm(ks[20], (L, D, 2 * F), D ** -0.5),
        "shared_w_down": nrm(ks[21], (L, F, D), F ** -0.5 * DN_BETA),
        "ln2_g": 1.0 + nrm(ks[22], (L, D), 0.05),
        "ln2_b": nrm(ks[23], (L, D), 0.02),
    }


def reference(x, w_in, rel_bias, pool_w, pool_scale, lambda_q1, lambda_k1, lambda_q2, lambda_k2,
              subln_g, w_branch_a, w_branch_b, w_branch_c, w_out, ln1_g, ln1_b, router_w, router_bias,
              expert_w_gate_up, expert_w_down, shared_w_gate_up, shared_w_down, ln2_g, ln2_b):
    B, S, D = x.shape
    cos, sin = rope_tables(S, x.dtype)
    for l in range(DEPTH):
        h = hybrid_mixer(x, l, w_in[l], rel_bias[l], pool_w[l], pool_scale[l],
                         lambda_q1[l], lambda_k1[l], lambda_q2[l], lambda_k2[l], subln_g[l],
                         w_branch_a[l], w_branch_b[l], w_branch_c[l], w_out[l], cos, sin)
        x = layer_norm(DN_ALPHA * x + h, ln1_g[l], ln1_b[l])
        xf = x.reshape(B * S, D)
        idx, wts = route(xf, router_w[l], router_bias[l])
        y = (routed_experts(xf, idx, wts, expert_w_gate_up[l], expert_w_down[l])
             + shared_expert(xf, shared_w_gate_up[l], shared_w_down[l]))
        x = layer_norm(DN_ALPHA * x + y.reshape(B, S, D), ln2_g[l], ln2_b[l])
    return x
```

```cpp
#include <hip/hip_runtime.h>
#include <stdint.h>
#include <stdio.h>
#include <math.h>

constexpr int NB = 4, SEQ = 4096, NTOK = NB * SEQ, DM = 1024, DEPTH = 4;
constexpr int DIN = 6656;
constexpr int C_UB = 1536;
constexpr int NEXP = 64, TOPK = 8, EDIM = 256;
constexpr int RELN = 513;
constexpr int MAXROWS = NTOK * TOPK + NTOK + NTOK;
constexpr float LN_EPS = 1e-5f;
constexpr float ROUTED_SCALE = 2.5f;

constexpr size_t MiB = 1u << 20;
constexpr size_t WS_CTL = 0;
constexpr size_t WS_SMALL = 1 * MiB;
constexpr size_t WS_XB = 32 * MiB;
constexpr size_t WS_Z = 96 * MiB;
constexpr size_t WS_YA = 512 * MiB, WS_YB = 544 * MiB, WS_YC = 576 * MiB;
constexpr size_t WS_MF = 608 * MiB;
constexpr size_t WS_MERGED = 672 * MiB;
constexpr size_t WS_HID = 736 * MiB;
constexpr size_t WS_YE = 896 * MiB;
constexpr size_t SM_IDX = 0, SM_WTS = 1 * MiB, SM_RANK = 2 * MiB, SM_POS = 3 * MiB, SM_ROWTOK = 4 * MiB, SM_OFF = 6 * MiB, SM_TILE = 6 * MiB + 4096, SM_NT = 6 * MiB + 16384, SM_LAM = 6 * MiB + 20480;
namespace pg8 {
#define PG8_LAS __attribute__((address_space(3)))
typedef short bf16x8 __attribute__((ext_vector_type(8)));
typedef float f32x4 __attribute__((ext_vector_type(4)));
typedef float f32x2 __attribute__((ext_vector_type(2)));
typedef unsigned u32x4 __attribute__((ext_vector_type(4)));
constexpr int BM = 256, BK = 64, HALF = 128, HTB = HALF * BK * 2  , STAGE_BYTES = 8 * HTB, NXCD = 8, WGM = 8;

__host__ __device__ __forceinline__ int lds_byte(int r, int c) { const int st = (r >> 4) * 2 + (c >> 5), rr = r & 15, cc = c & 31, ob = rr * 64 + cc * 2; return st * 1024 + (ob ^ (((ob >> 9) & 1) << 5)); }
__host__ __device__ __forceinline__ void stage_rc(int b, int& R, int& C) { const int st = b / 1024, sb = b % 1024, swz = sb ^ (((sb >> 9) & 1) << 5); R = (st >> 1) * 16 + swz / 64; C = (st & 1) * 32 + (swz % 64) / 2; }
__host__ __device__ __forceinline__ int perm32(int rho) { const int n = rho >> 4, i = rho & 15; return 8 * (i >> 2) + 4 * n + (i & 3); }

struct Unit { int pm, pn, e; };

__device__ __forceinline__ bool static_tile(int L, int nM, int nN, int& pm, int& pn) {
    const int nwg = nM * nN; if (L >= nwg) return false;
    int wgid = L; { const int q = nwg / NXCD, r = nwg % NXCD, xcd = wgid % NXCD, off = wgid / NXCD; wgid = (xcd < r ? xcd * (q + 1) : r * (q + 1) + (xcd - r) * q) + off; }
    const int nig = WGM * nN, gid = wgid / nig, fm = gid * WGM, gsz = (nM - fm) < WGM ? (nM - fm) : WGM;
    pm = fm + ((wgid % nig) % gsz); pn = (wgid % nig) / gsz; return true;
}
struct SchedDense {
    static constexpr bool GATHER = false;
    const char* A; const char* Bt; int nM, nN, G, c, K, pn0;
    __device__ __forceinline__ bool next(int i, Unit& u) const { u.e = 0; const bool ok = static_tile(i * G + c, nM, nN, u.pm, u.pn); u.pn += pn0; return ok; }
    __device__ __forceinline__ const char* a_ptr(const Unit& u) const { return A + (size_t)u.pm * (size_t)(BM * K * 2); }
    __device__ __forceinline__ const char* b_ptr(const Unit& u) const { return Bt + (size_t)u.pn * (size_t)(BM * K * 2); }
    __device__ __forceinline__ void offsA(int, const Unit&, const int (&)[2], const int (&)[2], unsigned (&)[2][2]) const {}
};
template <bool GATHER_> struct SchedGroup {
    static constexpr bool GATHER = GATHER_;
    const char* A; const char* Bt; const PG8_LAS int* ul; const PG8_LAS int* rt; int nu, K, NT;
    __device__ __forceinline__ bool next(int i, Unit& u) const { if (i >= nu) return false;
        u.pm = __builtin_amdgcn_readfirstlane(ul[4 * i]); u.pn = __builtin_amdgcn_readfirstlane(ul[4 * i + 1]); u.e = __builtin_amdgcn_readfirstlane(ul[4 * i + 2]); return true; }
    __device__ __forceinline__ const char* a_ptr(const Unit& u) const { return GATHER ? A : A + (size_t)u.pm * (size_t)(BM * K * 2); }
    __device__ __forceinline__ const char* b_ptr(const Unit& u) const { return Bt + (size_t)(u.e * NT + u.pn) * (size_t)(BM * K * 2); }
    __device__ __forceinline__ void offsA(int i, const Unit&, const int (&R)[2], const int (&C)[2], unsigned (&vo)[2][2]) const {
#pragma unroll
        for (int h = 0; h < 2; ++h)
#pragma unroll
            for (int j = 0; j < 2; ++j) vo[h][j] = (unsigned)(rt[256 * i + h * HALF + R[j]] * K + C[j]) * 2u;
    }
};

__device__ __forceinline__ unsigned cvt_pk_bf16(float lo, float hi) { unsigned r; asm("v_cvt_pk_bf16_f32 %0, %1, %2" : "=v"(r) : "v"(lo), "v"(hi)); return r; }
__device__ __forceinline__ u32x4 pack8(const f32x4 a, const f32x4 b) { u32x4 w; w.x = cvt_pk_bf16(a[0], a[1]); w.y = cvt_pk_bf16(a[2], a[3]); w.z = cvt_pk_bf16(b[0], b[1]); w.w = cvt_pk_bf16(b[2], b[3]); return w; }
__device__ __forceinline__ void st16(void* p, const u32x4 v) { __builtin_nontemporal_store(v, (u32x4*)p); }
__device__ __forceinline__ float bflo(unsigned w) { return __uint_as_float(w << 16); }
__device__ __forceinline__ float bfhi(unsigned w) { return __uint_as_float(w & 0xffff0000u); }
__device__ __forceinline__ float fast_sigmoid(float v) { return __builtin_amdgcn_rcpf(1.f + __builtin_amdgcn_exp2f(-1.4426950408889634f * v)); }


struct EpiInproj {
    static constexpr bool PERM = true;
    unsigned short* Z; const float* cs;
    __device__ __forceinline__ void operator()(const f32x4 (&acc)[2][2][4][2], const Unit& u, int wr, int wc, int fr, int fq) const {
        const int pn = u.pn;
        const int mode = pn < 2 ? 1 : (pn == 8 || pn == 9) ? 2 : (pn == 10 || pn == 11) ? 3 : (pn >= 14 ? 4 : 0);
        const float sc = (mode == 1 || mode == 2) ? 0.18033688011112042f : 1.f;
        const int row0 = u.pm * BM + wr * 64 + fr, col0 = pn * BM + wc * 32 + 8 * fq;
        if ((mode == 2 || mode == 3) && ((wc & 1) == 0)) {
            const float sgn = (fq == 0) ? -1.f : 1.f;
#pragma unroll
            for (int ai = 0; ai < 2; ++ai)
#pragma unroll
                for (int m = 0; m < 4; ++m) {
                    const int row = row0 + ai * HALF + m * 16;
                    const float* cp = cs + (size_t)(row & 4095) * 16; const f32x4 cc0 = *(const f32x4*)cp, cc1 = *(const f32x4*)(cp + 4), ss0 = *(const f32x4*)(cp + 8), ss1 = *(const f32x4*)(cp + 12);
                    unsigned short* rowp = Z + (size_t)row * 6656 + col0;
#pragma unroll
                    for (int bj = 0; bj < 2; ++bj) {
                        f32x4 v0 = acc[ai][bj][m][0], v1 = acc[ai][bj][m][1], p0, p1;
#pragma unroll
                        for (int j = 0; j < 4; ++j) { p0[j] = __shfl_xor(v0[j], 16); p1[j] = __shfl_xor(v1[j], 16); }
                        if (fq < 2) { v0 = v0 * cc0 + (p0 * ss0) * sgn; v1 = v1 * cc1 + (p1 * ss1) * sgn; }
                        v0 = v0 * sc; v1 = v1 * sc;
                        st16(rowp + bj * HALF, pack8(v0, v1));
                    }
                }
        } else if (mode == 4) {
#pragma unroll
            for (int ai = 0; ai < 2; ++ai)
#pragma unroll
                for (int m = 0; m < 4; ++m) { unsigned short* rowp = Z + (size_t)(row0 + ai * HALF + m * 16) * 6656 + col0;
#pragma unroll
                    for (int bj = 0; bj < 2; ++bj) { f32x4 v0 = acc[ai][bj][m][0], v1 = acc[ai][bj][m][1];
#pragma unroll
                        for (int j = 0; j < 4; ++j) { v0[j] = fast_sigmoid(v0[j]); v1[j] = fast_sigmoid(v1[j]); }
                        st16(rowp + bj * HALF, pack8(v0, v1)); } }
        } else {
#pragma unroll
            for (int ai = 0; ai < 2; ++ai)
#pragma unroll
                for (int m = 0; m < 4; ++m) { unsigned short* rowp = Z + (size_t)(row0 + ai * HALF + m * 16) * 6656 + col0;
#pragma unroll
                    for (int bj = 0; bj < 2; ++bj) st16(rowp + bj * HALF, pack8(acc[ai][bj][m][0] * sc, acc[ai][bj][m][1] * sc)); }
        }
    }
};
struct EpiWout {
    static constexpr bool PERM = true;
    unsigned short* xb; float alpha; int pad;
    __device__ __forceinline__ void operator()(const f32x4 (&acc)[2][2][4][2], const Unit& u, int wr, int wc, int fr, int fq) const {
        const int row0 = u.pm * BM + wr * 64 + fr, col0 = u.pn * BM + wc * 32 + 8 * fq;
#pragma unroll
        for (int ai = 0; ai < 2; ++ai)
#pragma unroll
            for (int mh = 0; mh < 2; ++mh) {
                u32x4 pre[2][2];
#pragma unroll
                for (int mm = 0; mm < 2; ++mm)
#pragma unroll
                    for (int bj = 0; bj < 2; ++bj) pre[mm][bj] = *(const u32x4*)(xb + (size_t)(row0 + ai * HALF + (2 * mh + mm) * 16) * 1024 + col0 + bj * HALF);
#pragma unroll
                for (int mm = 0; mm < 2; ++mm)
#pragma unroll
                    for (int bj = 0; bj < 2; ++bj) { const int m = 2 * mh + mm; const u32x4 p = pre[mm][bj]; f32x4 v0 = acc[ai][bj][m][0], v1 = acc[ai][bj][m][1];
                        v0[0] += alpha * bflo(p.x); v0[1] += alpha * bfhi(p.x); v0[2] += alpha * bflo(p.y); v0[3] += alpha * bfhi(p.y); v1[0] += alpha * bflo(p.z); v1[1] += alpha * bfhi(p.z); v1[2] += alpha * bflo(p.w); v1[3] += alpha * bfhi(p.w);
                        st16(xb + (size_t)(row0 + ai * HALF + m * 16) * 1024 + col0 + bj * HALF, pack8(v0, v1)); }
                asm volatile("" ::: "memory");
            }
    }
};
struct EpiGateUp {
    static constexpr bool PERM = true;
    unsigned short* HID;
    __device__ __forceinline__ void operator()(const f32x4 (&acc)[2][2][4][2], const Unit& u, int wr, int wc, int fr, int fq) const {
        const int row0 = u.pm * BM + wr * 64 + fr, col0 = u.pn * HALF + wc * 32 + 8 * fq;
#pragma unroll
        for (int ai = 0; ai < 2; ++ai)
#pragma unroll
            for (int m = 0; m < 4; ++m) {
                f32x4 h0, h1;
#pragma unroll
                for (int j = 0; j < 4; ++j) { const float g0 = acc[ai][0][m][0][j], g1 = acc[ai][0][m][1][j]; h0[j] = g0 * fast_sigmoid(g0) * acc[ai][1][m][0][j]; h1[j] = g1 * fast_sigmoid(g1) * acc[ai][1][m][1][j]; }
                st16(HID + (size_t)(row0 + ai * HALF + m * 16) * 256 + col0, pack8(h0, h1));
            }
    }
};
struct EpiStore {
    static constexpr bool PERM = true;
    unsigned short* O; int ldc; int pad;
    __device__ __forceinline__ void operator()(const f32x4 (&acc)[2][2][4][2], const Unit& u, int wr, int wc, int fr, int fq) const {
        const int row0 = u.pm * BM + wr * 64 + fr, col0 = u.pn * BM + wc * 32 + 8 * fq;
#pragma unroll
        for (int ai = 0; ai < 2; ++ai)
#pragma unroll
            for (int m = 0; m < 4; ++m) { unsigned short* rowp = O + (size_t)(row0 + ai * HALF + m * 16) * ldc + col0;
#pragma unroll
                for (int bj = 0; bj < 2; ++bj) st16(rowp + bj * HALF, pack8(acc[ai][bj][m][0], acc[ai][bj][m][1])); }
    }
};

template <class Epi, class Sched, bool ALIGN_EPI>
__device__ __forceinline__ void gemm_phase(PG8_LAS unsigned char* lds, const int K, const Sched& S, const Epi& E) {
    int tid_ = threadIdx.x; asm volatile("" : "+v"(tid_));
    const int tid = tid_, wid = __builtin_amdgcn_readfirstlane(tid >> 6), lane = tid & 63, wr = wid >> 2, wc = wid & 3, fr = lane & 15, fq = lane >> 4;
    const int nt = K / BK;
    int Rr[2], Cc[2];
    unsigned voffA[2][2], voffB[2];
#pragma unroll
    for (int i = 0; i < 2; ++i) { stage_rc(tid * 16 + i * 8192, Rr[i], Cc[i]); const int Rb = Epi::PERM ? ((Rr[i] & ~31) + perm32(Rr[i] & 31)) : Rr[i];
        voffA[0][i] = (unsigned)(Rr[i] * K + Cc[i]) * 2u; voffA[1][i] = (unsigned)((Rr[i] + HALF) * K + Cc[i]) * 2u; voffB[i] = (unsigned)(Rb * K + Cc[i]) * 2u; }
    const size_t kstep = (size_t)(BK * 2);
    const size_t hstep = (size_t)HALF * K * 2;
    const unsigned ldsw = (unsigned)wid * 1024u;
    const int aoff = lds_byte(wr * 64 + fr, fq * 8), boff = lds_byte(wc * 32 + fr, fq * 8);
#define PG8_SA(b, h) (((b) * 2 + (h)) * HTB)
#define PG8_SB(b, h) ((4 + (b) * 2 + (h)) * HTB)
#define PG8_STAGE(bufoff, gbase, voff) do { _Pragma("unroll") for (int _i = 0; _i < 2; ++_i) \
        __builtin_amdgcn_global_load_lds((const unsigned*)((const char*)(gbase) + (voff)[_i]), (PG8_LAS unsigned*)(lds + (bufoff) + ldsw + _i * 8192), 16, 0, 0); } while (0)
#define PG8_LDA(dst, b, h) do { _Pragma("unroll") for (int m = 0; m < 4; ++m) _Pragma("unroll") for (int k = 0; k < 2; ++k) dst[m][k] = *(const PG8_LAS bf16x8*)(lds + PG8_SA(b, h) + aoff + m * 2048 + k * 1024); } while (0)
#define PG8_LDB(dst, b, h) do { _Pragma("unroll") for (int n = 0; n < 2; ++n) _Pragma("unroll") for (int k = 0; k < 2; ++k) dst[n][k] = *(const PG8_LAS bf16x8*)(lds + PG8_SB(b, h) + boff + n * 2048 + k * 1024); } while (0)
#define PG8_MMA(ai, bj, At, Bt) do { __builtin_amdgcn_s_setprio(1); _Pragma("unroll") for (int m = 0; m < 4; ++m) _Pragma("unroll") for (int n = 0; n < 2; ++n) _Pragma("unroll") for (int k = 0; k < 2; ++k) \
        acc[ai][bj][m][n] = __builtin_amdgcn_mfma_f32_16x16x32_bf16(Bt[n][k], At[m][k], acc[ai][bj][m][n], 0, 0, 0); __builtin_amdgcn_s_setprio(0); } while (0)
#define PG8_WAIT_V(n) asm volatile("s_waitcnt vmcnt(" #n ")" ::: "memory")
#define PG8_WAIT_L(n) asm volatile("s_waitcnt lgkmcnt(" #n ")" ::: "memory")
#define PG8_BAR __builtin_amdgcn_s_barrier()
#define PG8_SCHED __builtin_amdgcn_sched_barrier(0)
    Unit cur, nxt; int ui = 0;
    if (!S.next(0, cur)) return;
    if constexpr (Sched::GATHER) S.offsA(0, cur, Rr, Cc, voffA);
    f32x4 acc[2][2][4][2];
#pragma unroll
    for (int a = 0; a < 2; ++a)
#pragma unroll
        for (int b = 0; b < 2; ++b)
#pragma unroll
            for (int m = 0; m < 4; ++m)
#pragma unroll
                for (int n = 0; n < 2; ++n) acc[a][b][m][n] = (f32x4){0.f, 0.f, 0.f, 0.f};
    bf16x8 At[4][2], B0[2][2], B1[2][2];
    const char* cA = S.a_ptr(cur); const char* cB = S.b_ptr(cur);
    PG8_STAGE(PG8_SB(0, 0), cB, voffB); PG8_STAGE(PG8_SB(0, 1), cB + hstep, voffB); PG8_STAGE(PG8_SA(0, 0), cA, voffA[0]); PG8_STAGE(PG8_SA(0, 1), cA, voffA[1]);
    if (wr == 1) PG8_BAR;
    PG8_WAIT_V(2); PG8_BAR;
    PG8_STAGE(PG8_SB(1, 0), cB + kstep, voffB); PG8_STAGE(PG8_SA(1, 0), cA + kstep, voffA[0]); PG8_STAGE(PG8_SB(1, 1), cB + hstep + kstep, voffB);
    PG8_WAIT_V(6); PG8_BAR;
    for (;;) {
        const bool has_next = S.next(ui + 1, nxt);
        const char* nA = has_next ? S.a_ptr(nxt) : cA; const char* nB = has_next ? S.b_ptr(nxt) : cB;
#pragma clang loop unroll(disable)
        for (int t = 0; t < nt; t += 2) {
            const bool last = (t == nt - 2);
            const char* a1 = cA + (size_t)(t + 1) * kstep;
            const char* a2 = last ? nA : cA + (size_t)(t + 2) * kstep; const char* b2 = last ? nB : cB + (size_t)(t + 2) * kstep;
            const char* a3 = a2 + kstep; const char* b3 = b2 + kstep;
            PG8_LDB(B0, 0, 0); PG8_LDB(B1, 0, 1); PG8_SCHED; PG8_LDA(At, 0, 0); PG8_STAGE(PG8_SA(1, 1), a1, voffA[1]);
            if constexpr (Sched::GATHER) { if (last && has_next) S.offsA(ui + 1, nxt, Rr, Cc, voffA); }
            PG8_WAIT_V(8); PG8_WAIT_L(0); PG8_BAR; PG8_MMA(0, 0, At, B0); PG8_MMA(0, 1, At, B1); PG8_BAR; PG8_SCHED;
            PG8_LDA(At, 0, 1); PG8_STAGE(PG8_SB(0, 0), b2, voffB); PG8_STAGE(PG8_SB(0, 1), b2 + hstep, voffB); PG8_STAGE(PG8_SA(0, 0), a2, voffA[0]);
            PG8_WAIT_V(8); PG8_WAIT_L(0); PG8_BAR; PG8_MMA(1, 0, At, B0); PG8_MMA(1, 1, At, B1); PG8_BAR; PG8_SCHED;
            PG8_LDB(B0, 1, 0); PG8_LDB(B1, 1, 1); PG8_SCHED; PG8_LDA(At, 1, 0); PG8_STAGE(PG8_SA(0, 1), a2, voffA[1]);
            PG8_WAIT_V(8); PG8_WAIT_L(0); PG8_BAR; PG8_MMA(0, 0, At, B0); PG8_MMA(0, 1, At, B1); PG8_BAR; PG8_SCHED;
            PG8_LDA(At, 1, 1); PG8_STAGE(PG8_SB(1, 0), b3, voffB); PG8_STAGE(PG8_SB(1, 1), b3 + hstep, voffB); PG8_STAGE(PG8_SA(1, 0), a3, voffA[0]);
            PG8_WAIT_V(8); PG8_WAIT_L(0); PG8_BAR; PG8_MMA(1, 0, At, B0); PG8_MMA(1, 1, At, B1); PG8_BAR; PG8_SCHED;
        }
        if constexpr (ALIGN_EPI) { if (wr == 0) PG8_BAR; }
        E(acc, cur, wr, wc, fr, fq);
        if (!has_next) break;
#pragma unroll
        for (int a = 0; a < 2; ++a)
#pragma unroll
            for (int b = 0; b < 2; ++b)
#pragma unroll
                for (int m = 0; m < 4; ++m)
#pragma unroll
                    for (int n = 0; n < 2; ++n) acc[a][b][m][n] = (f32x4){0.f, 0.f, 0.f, 0.f};
        cur = nxt; cA = nA; cB = nB; ++ui;
        if constexpr (ALIGN_EPI) { if (wr == 1) PG8_BAR; }
    }
    PG8_WAIT_V(0);
    if constexpr (!ALIGN_EPI) { if (wr == 0) PG8_BAR; }
    PG8_BAR;
#undef PG8_SA
#undef PG8_SB
#undef PG8_STAGE
#undef PG8_LDA
#undef PG8_LDB
#undef PG8_MMA
#undef PG8_WAIT_V
#undef PG8_WAIT_L
#undef PG8_BAR
#undef PG8_SCHED
}
struct SchedBranchHN {
    static constexpr bool GATHER = false;
    const char* A; const char* Bt; size_t astride, bstride; int G, c, K;
    __device__ __forceinline__ bool next(int i, Unit& u) const { u.e = i % 3; const int L = (i / 3) * G + c; if (L >= 512) return false; u.pm = L >> 3; u.pn = L & 7; return true; }
    __device__ __forceinline__ const char* a_ptr(const Unit& u) const { return A + (size_t)u.e * astride + (size_t)u.pm * (size_t)(BM * K * 2); }
    __device__ __forceinline__ const char* b_ptr(const Unit& u) const { return Bt + (size_t)u.e * bstride + (size_t)u.pn * (size_t)(HALF * K * 2); }
};
struct EpiBranchHN {
    unsigned short* merged; const unsigned short* Z;
    __device__ __forceinline__ void operator()(const f32x4 (&acc)[2][4][2], f32x4 (&tot)[2][4][2], const Unit& u, int wr, int wc, int fr, int fq) const {
        const int br = u.e; const int row0 = u.pm * BM + wr * 64 + fr, col0 = u.pn * HALF + wc * 32 + 8 * fq;
        const unsigned short* gbase = Z + 3584 + br * 1024 + col0;
#pragma unroll
        for (int ai = 0; ai < 2; ++ai) {
            u32x4 gt[4];
#pragma unroll
            for (int m = 0; m < 4; ++m) gt[m] = *(const u32x4*)(gbase + (size_t)(row0 + ai * HALF + m * 16) * 6656);
#pragma unroll
            for (int m = 0; m < 4; ++m) { const u32x4 gg = gt[m]; f32x4 v0 = acc[ai][m][0], v1 = acc[ai][m][1];
                v0[0] *= bflo(gg.x); v0[1] *= bfhi(gg.x); v0[2] *= bflo(gg.y); v0[3] *= bfhi(gg.y); v1[0] *= bflo(gg.z); v1[1] *= bfhi(gg.z); v1[2] *= bflo(gg.w); v1[3] *= bfhi(gg.w);
                if (br == 0) { tot[ai][m][0] = v0; tot[ai][m][1] = v1; } else { tot[ai][m][0] += v0; tot[ai][m][1] += v1; }
                if (br == 2) st16(merged + (size_t)(row0 + ai * HALF + m * 16) * 1024 + col0, pack8(tot[ai][m][0], tot[ai][m][1])); }
            asm volatile("" ::: "memory");
        }
    }
};
template <class Epi, class Sched>
__device__ __forceinline__ void gemm_phase_hn(PG8_LAS unsigned char* lds, const int K, const Sched& S, const Epi& E) {
    int tid_ = threadIdx.x; asm volatile("" : "+v"(tid_));
    const int tid = tid_, wid = __builtin_amdgcn_readfirstlane(tid >> 6), lane = tid & 63, wr = wid >> 2, wc = wid & 3, fr = lane & 15, fq = lane >> 4;
    const int nt = K / BK;
    unsigned voffA[2][2], voffB[2];
#pragma unroll
    for (int i = 0; i < 2; ++i) { int R, C; stage_rc(tid * 16 + i * 8192, R, C); const int Rb = (R & ~31) + perm32(R & 31);
        voffA[0][i] = (unsigned)(R * K + C) * 2u; voffA[1][i] = (unsigned)((R + HALF) * K + C) * 2u; voffB[i] = (unsigned)(Rb * K + C) * 2u; }
    const size_t kstep = (size_t)(BK * 2);
    const unsigned ldsw = (unsigned)wid * 1024u;
    const int aoff = lds_byte(wr * 64 + fr, fq * 8), boff = lds_byte(wc * 32 + fr, fq * 8);
#define PG8_SA(b, h) (((b) * 2 + (h)) * HTB)
#define PG8_SB(b, h) ((4 + (b) * 2 + (h)) * HTB)
#define PG8_STAGE(bufoff, gbase, voff) do { _Pragma("unroll") for (int _i = 0; _i < 2; ++_i) \
        __builtin_amdgcn_global_load_lds((const unsigned*)((const char*)(gbase) + (voff)[_i]), (PG8_LAS unsigned*)(lds + (bufoff) + ldsw + _i * 8192), 16, 0, 0); } while (0)
#define PG8_LDA(dst, b, h) do { _Pragma("unroll") for (int m = 0; m < 4; ++m) _Pragma("unroll") for (int k = 0; k < 2; ++k) dst[m][k] = *(const PG8_LAS bf16x8*)(lds + PG8_SA(b, h) + aoff + m * 2048 + k * 1024); } while (0)
#define PG8_LDB(dst, b, h) do { _Pragma("unroll") for (int n = 0; n < 2; ++n) _Pragma("unroll") for (int k = 0; k < 2; ++k) dst[n][k] = *(const PG8_LAS bf16x8*)(lds + PG8_SB(b, h) + boff + n * 2048 + k * 1024); } while (0)
#define PG8_MMA(ai, At, Bt) do { __builtin_amdgcn_s_setprio(1); _Pragma("unroll") for (int m = 0; m < 4; ++m) _Pragma("unroll") for (int n = 0; n < 2; ++n) _Pragma("unroll") for (int k = 0; k < 2; ++k) \
        acc[ai][m][n] = __builtin_amdgcn_mfma_f32_16x16x32_bf16(Bt[n][k], At[m][k], acc[ai][m][n], 0, 0, 0); __builtin_amdgcn_s_setprio(0); } while (0)
#define PG8_WAIT_V(n) asm volatile("s_waitcnt vmcnt(" #n ")" ::: "memory")
#define PG8_WAIT_L(n) asm volatile("s_waitcnt lgkmcnt(" #n ")" ::: "memory")
#define PG8_BAR __builtin_amdgcn_s_barrier()
#define PG8_SCHED __builtin_amdgcn_sched_barrier(0)
    Unit cur, nxt; int ui = 0;
    if (!S.next(0, cur)) return;
    f32x4 acc[2][4][2], tot[2][4][2];
#pragma unroll
    for (int a = 0; a < 2; ++a)
#pragma unroll
        for (int m = 0; m < 4; ++m)
#pragma unroll
            for (int n = 0; n < 2; ++n) { acc[a][m][n] = (f32x4){0.f, 0.f, 0.f, 0.f}; tot[a][m][n] = (f32x4){0.f, 0.f, 0.f, 0.f}; }
    bf16x8 At[4][2], B0[2][2];
    const char* cA = S.a_ptr(cur); const char* cB = S.b_ptr(cur);
    PG8_STAGE(PG8_SB(0, 0), cB, voffB); PG8_STAGE(PG8_SA(0, 0), cA, voffA[0]); PG8_STAGE(PG8_SA(0, 1), cA, voffA[1]);
    if (wr == 1) PG8_BAR;
    PG8_WAIT_V(2); PG8_BAR;
    PG8_STAGE(PG8_SB(1, 0), cB + kstep, voffB); PG8_STAGE(PG8_SA(1, 0), cA + kstep, voffA[0]);
    PG8_WAIT_V(4); PG8_BAR;
    for (;;) {
        const bool has_next = S.next(ui + 1, nxt);
        const char* nA = has_next ? S.a_ptr(nxt) : cA; const char* nB = has_next ? S.b_ptr(nxt) : cB;
#pragma clang loop unroll(disable)
        for (int t = 0; t < nt; t += 2) {
            const bool last = (t == nt - 2);
            const char* a1 = cA + (size_t)(t + 1) * kstep;
            const char* a2 = last ? nA : cA + (size_t)(t + 2) * kstep; const char* b2 = last ? nB : cB + (size_t)(t + 2) * kstep;
            const char* a3 = a2 + kstep; const char* b3 = b2 + kstep;
            PG8_LDB(B0, 0, 0); PG8_SCHED; PG8_LDA(At, 0, 0); PG8_STAGE(PG8_SA(1, 1), a1, voffA[1]);
            PG8_WAIT_V(6); PG8_WAIT_L(0); PG8_BAR; PG8_MMA(0, At, B0); PG8_BAR; PG8_SCHED;
            PG8_LDA(At, 0, 1); PG8_STAGE(PG8_SB(0, 0), b2, voffB); PG8_STAGE(PG8_SA(0, 0), a2, voffA[0]);
            PG8_WAIT_V(6); PG8_WAIT_L(0); PG8_BAR; PG8_MMA(1, At, B0); PG8_BAR; PG8_SCHED;
            PG8_LDB(B0, 1, 0); PG8_SCHED; PG8_LDA(At, 1, 0); PG8_STAGE(PG8_SA(0, 1), a2, voffA[1]);
            PG8_WAIT_V(6); PG8_WAIT_L(0); PG8_BAR; PG8_MMA(0, At, B0); PG8_BAR; PG8_SCHED;
            PG8_LDA(At, 1, 1); PG8_STAGE(PG8_SB(1, 0), b3, voffB); PG8_STAGE(PG8_SA(1, 0), a3, voffA[0]);
            PG8_WAIT_V(6); PG8_WAIT_L(0); PG8_BAR; PG8_MMA(1, At, B0); PG8_BAR; PG8_SCHED;
        }
        if (wr == 0) PG8_BAR;
        E(acc, tot, cur, wr, wc, fr, fq);
        if (!has_next) break;
#pragma unroll
        for (int a = 0; a < 2; ++a)
#pragma unroll
            for (int m = 0; m < 4; ++m)
#pragma unroll
                for (int n = 0; n < 2; ++n) acc[a][m][n] = (f32x4){0.f, 0.f, 0.f, 0.f};
        cur = nxt; cA = nA; cB = nB; ++ui;
        if (wr == 1) PG8_BAR;
    }
    PG8_WAIT_V(0);
    PG8_BAR;
#undef PG8_SA
#undef PG8_SB
#undef PG8_STAGE
#undef PG8_LDA
#undef PG8_LDB
#undef PG8_MMA
#undef PG8_WAIT_V
#undef PG8_WAIT_L
#undef PG8_BAR
#undef PG8_SCHED
}
}
namespace att {
#define ATT_LAS __attribute__((address_space(3)))
typedef short bf16x8 __attribute__((ext_vector_type(8)));
typedef short s16x4 __attribute__((ext_vector_type(4)));
typedef float f32x16 __attribute__((ext_vector_type(16)));
typedef unsigned u32x4 __attribute__((ext_vector_type(4)));
constexpr int ZP = 6656;
constexpr int BUFB = 32768;
constexpr int NBUF = 3;
constexpr int L_WSF = NBUF * BUFB, L_BIAS = L_WSF + 8 * 256, L_END = L_BIAS + 2 * 520 * 4;
__device__ __forceinline__ int crow(int r, int hi) { return (r & 3) + 8 * (r >> 2) + 4 * hi; }
__device__ __forceinline__ unsigned cvtpk(float lo, float hi) { unsigned r; asm("v_cvt_pk_bf16_f32 %0, %1, %2" : "=v"(r) : "v"(lo), "v"(hi)); return r; }
__device__ __forceinline__ s16x4 vtr(const ATT_LAS unsigned char* p) { typedef short v4i16_t __attribute__((ext_vector_type(4)));
    return __builtin_bit_cast(s16x4, __builtin_amdgcn_ds_read_tr16_b64_v4i16((ATT_LAS v4i16_t*)p)); }

__device__ __forceinline__ void issue_tile(ATT_LAS unsigned char* lds, int boff, const unsigned short* Z, int krow0, int kcol, int vcol, int wid, int lane) {
#pragma unroll
    for (int j = 0; j < 2; ++j) {
        const int pc = 2 * wid + j, s = pc >> 3, c = pc & 7;
        const unsigned short* ks = Z + (size_t)(krow0 + lane) * ZP + kcol + s * 64 + c * 8;
        __builtin_amdgcn_global_load_lds((const unsigned*)ks, (ATT_LAS unsigned*)(lds + boff + s * 8192 + c * 1024), 16, 0, 0);
        const unsigned short* vs = Z + (size_t)(krow0 + 16 * (c & 3) + (lane >> 2)) * ZP + vcol + s * 64 + (c >> 2) * 32 + (lane & 3) * 8;
        __builtin_amdgcn_global_load_lds((const unsigned*)vs, (ATT_LAS unsigned*)(lds + boff + 16384 + s * 8192 + c * 1024), 16, 0, 0);
    }
}

template <int MODE>
__device__ __forceinline__ void attn_unit(ATT_LAS unsigned char* lds, const unsigned short* __restrict__ Z, int b, int hp, int qb, const float* __restrict__ bias, float lam, float oml, const float* __restrict__ subg, unsigned short* __restrict__ Y) {
    constexpr int NDB = MODE ? 4 : 2;
    int tid_ = threadIdx.x; asm volatile("" : "+v"(tid_));
    const int tid = tid_, lane = tid & 63, r32 = lane & 31, hi = lane >> 5, wid = __builtin_amdgcn_readfirstlane(tid >> 6), grp = wid >> 2, wq = wid & 3;
    const int rowbase = b * 4096, q0 = qb * 128 + wq * 32, qc = 2 * qb + (wq >> 1);
    const int qcol = MODE ? (2048 + hp * 128 + grp * 64) : (0 + (2 * hp + grp) * 64);
    const int kcol = MODE ? (2560 + hp * 128) : (512 + hp * 128), vcol = MODE ? (3072 + hp * 128) : (1024 + hp * 128);
    const int t_lo = MODE ? 0 : ((2 * qb - 8) > 0 ? (2 * qb - 8) : 0), t_hi = 2 * qb + 1;
    ATT_LAS float* wsf = (ATT_LAS float*)(lds + L_WSF) + wid * 64;
    ATT_LAS float* bl = (ATT_LAS float*)(lds + L_BIAS);
    issue_tile(lds, 0, Z, rowbase + t_lo * 64, kcol, vcol, wid, lane);
    issue_tile(lds, BUFB, Z, rowbase + (t_lo + 1) * 64, kcol, vcol, wid, lane);
    if (MODE == 0) { for (int i = tid; i < 2 * 513; i += 512) { const int g = i / 513, j = i % 513; bl[g * 520 + j] = bias[(2 * hp + g) * 513 + j] * 1.4426950408889634f; } }
    bf16x8 qr[4];
#pragma unroll
    for (int d0 = 0; d0 < 4; ++d0) qr[d0] = *(const bf16x8*)(Z + (size_t)(rowbase + q0 + r32) * ZP + qcol + d0 * 16 + hi * 8);
    f32x16 o[NDB];
#pragma unroll
    for (int d = 0; d < NDB; ++d) o[d] = f32x16{};
    float m_run = -INFINITY, l_run = 0.f;
    const int vlane = ((lane >> 4) & 1) * 32 + (lane & 3) * 8 + (4 * hi + ((lane & 15) >> 2)) * 64;
    int bi = 0;
    for (int t = t_lo; t <= t_hi; ++t) {
        const int boff = bi * BUFB;
        if (t < t_hi) asm volatile("s_waitcnt vmcnt(4) lgkmcnt(0)\n\ts_barrier" ::: "memory");
        else asm volatile("s_waitcnt vmcnt(0) lgkmcnt(0)\n\ts_barrier" ::: "memory");
        { const int b2 = (bi == 0) ? 2 : bi - 1;
          if (t + 2 <= t_hi) issue_tile(lds, b2 * BUFB, Z, rowbase + (t + 2) * 64, kcol, vcol, wid, lane); }
        bi = (bi == NBUF - 1) ? 0 : bi + 1;
        const bool active = MODE ? (t <= qc) : (t >= qc - 8 && t <= qc);
        if (active) {
            f32x16 p0 = f32x16{}, p1 = f32x16{};
            const ATT_LAS unsigned char* kb = lds + boff + grp * 8192 + hi * 1024 + r32 * 16;
#pragma unroll
            for (int d0 = 0; d0 < 4; ++d0) {
                const bf16x8 b0 = *(const ATT_LAS bf16x8*)(kb + d0 * 2048), b1 = *(const ATT_LAS bf16x8*)(kb + d0 * 2048 + 512);
                p0 = __builtin_amdgcn_mfma_f32_32x32x16_bf16(b0, qr[d0], p0, 0, 0, 0);
                p1 = __builtin_amdgcn_mfma_f32_32x32x16_bf16(b1, qr[d0], p1, 0, 0, 0);
            }
            if (MODE == 0) {
                const int dc = qc - t;
                const ATT_LAS float* bg = bl + grp * 520;
                if (dc >= 5) { const float cb = bg[512];
#pragma unroll
                    for (int r = 0; r < 16; ++r) { p0[r] += cb; p1[r] += cb; } }
                else { const int base = dc * 64 + (wq & 1) * 32 + r32 + 256;
#pragma unroll
                    for (int r = 0; r < 16; ++r) { int i0 = base - crow(r, hi), i1 = i0 - 32; i0 = i0 > 512 ? 512 : i0; i1 = i1 > 512 ? 512 : i1; p0[r] += bg[i0]; p1[r] += bg[i1]; } }
            }
            float rm = p0[0];
#pragma unroll
            for (int r = 1; r < 16; ++r) rm = fmaxf(rm, p0[r]);
#pragma unroll
            for (int r = 0; r < 16; ++r) rm = fmaxf(rm, p1[r]);
            rm = fmaxf(rm, __shfl_xor(rm, 32));
            if (__any(rm > m_run + 8.0f)) {
                const float mn = fmaxf(m_run, rm); const float alpha = __builtin_amdgcn_exp2f(m_run - mn); m_run = mn; l_run *= alpha;
                if (hi == 0) wsf[r32] = alpha;
                asm volatile("s_waitcnt lgkmcnt(0)" ::: "memory");
#pragma unroll
                for (int r = 0; r < 16; ++r) { const float a = wsf[crow(r, hi)];
#pragma unroll
                    for (int d = 0; d < NDB; ++d) o[d][r] *= a; }
            }
            float ls = 0.f;
#pragma unroll
            for (int r = 0; r < 16; ++r) { p0[r] = __builtin_amdgcn_exp2f(p0[r] - m_run); p1[r] = __builtin_amdgcn_exp2f(p1[r] - m_run); ls += p0[r] + p1[r]; }
            l_run += ls;
            u32x4 pw[4];
#pragma unroll
            for (int j = 0; j < 4; ++j) { pw[0][j] = cvtpk(p0[2 * j], p0[2 * j + 1]); pw[1][j] = cvtpk(p0[8 + 2 * j], p0[9 + 2 * j]); pw[2][j] = cvtpk(p1[2 * j], p1[2 * j + 1]); pw[3][j] = cvtpk(p1[8 + 2 * j], p1[9 + 2 * j]); }
#pragma unroll
            for (int d = 0; d < NDB; ++d) {
                const int voff = 16384 + (MODE ? ((d >> 1) * 8192 + (d & 1) * 4096) : (grp * 8192 + d * 4096));
                const ATT_LAS unsigned char* vp = lds + boff + voff + vlane;
                s16x4 vl[4], vh[4];
#pragma unroll
                for (int ks = 0; ks < 4; ++ks) { vl[ks] = vtr(vp + ks * 1024); vh[ks] = vtr(vp + ks * 1024 + 512); }
#pragma unroll
                for (int ks = 0; ks < 4; ++ks) { const bf16x8 vf = (bf16x8){vl[ks][0], vl[ks][1], vl[ks][2], vl[ks][3], vh[ks][0], vh[ks][1], vh[ks][2], vh[ks][3]};
                    o[d] = __builtin_amdgcn_mfma_f32_32x32x16_bf16(__builtin_bit_cast(bf16x8, pw[ks]), vf, o[d], 0, 0, 0); }
            }
        }
    }
    __syncthreads();
    const float lfull = l_run + __shfl_xor(l_run, 32);
    const size_t yrow0 = (size_t)(rowbase + q0);
    if (MODE == 0) {
        if (hi == 0) wsf[r32] = __builtin_amdgcn_rcpf(lfull);
        asm volatile("s_waitcnt lgkmcnt(0)" ::: "memory");
        ATT_LAS unsigned short* stg = (ATT_LAS unsigned short*)(lds + wid * 4096);
#pragma unroll
        for (int r = 0; r < 16; ++r) { const float a = wsf[crow(r, hi)];
#pragma unroll
            for (int d = 0; d < NDB; ++d) stg[crow(r, hi) * 64 + d * 32 + r32] = (unsigned short)(cvtpk(o[d][r] * a, 0.f) & 0xffffu); }
        asm volatile("s_waitcnt lgkmcnt(0)" ::: "memory");
#pragma unroll
        for (int i = 0; i < 4; ++i) { const int row = i * 8 + (lane >> 3), ch = lane & 7; const u32x4 v = *(const ATT_LAS u32x4*)(stg + row * 64 + ch * 8);
            __builtin_nontemporal_store(v, (u32x4*)(Y + (yrow0 + row) * 512 + (2 * hp + grp) * 64 + ch * 8)); }
    } else {
        ATT_LAS float* xch = (ATT_LAS float*)lds;
        if (hi == 0) wsf[r32] = (grp ? lam : 1.f) * __builtin_amdgcn_rcpf(lfull);
        asm volatile("s_waitcnt lgkmcnt(0)" ::: "memory");
        float a[16];
#pragma unroll
        for (int r = 0; r < 16; ++r) a[r] = wsf[crow(r, hi)];
        if (grp == 1) {
#pragma unroll
            for (int r = 0; r < 16; ++r)
#pragma unroll
                for (int d = 0; d < NDB; ++d) xch[((wq * 16 + r) * 4 + d) * 64 + lane] = o[d][r] * a[r];
        }
        __syncthreads();
        if (grp == 0) {
            float ssq[16];
#pragma unroll
            for (int r = 0; r < 16; ++r) { float s = 0.f;
#pragma unroll
                for (int d = 0; d < NDB; ++d) { const float v = o[d][r] * a[r] - xch[((wq * 16 + r) * 4 + d) * 64 + lane]; o[d][r] = v; s += v * v; }
                ssq[r] = s; }
#pragma unroll
            for (int r = 0; r < 16; ++r) {
#pragma unroll
                for (int of = 1; of < 32; of <<= 1) ssq[r] += __shfl_xor(ssq[r], of);
            }
            float gs[NDB];
#pragma unroll
            for (int d = 0; d < NDB; ++d) gs[d] = subg[d * 32 + r32] * oml;
            ATT_LAS unsigned short* stg1 = (ATT_LAS unsigned short*)(lds + L_END + 64 + wq * 8192);
#pragma unroll
            for (int r = 0; r < 16; ++r) { const float rs = __builtin_amdgcn_rsqf(ssq[r] * (1.0f / 128.0f) + 1e-5f);
#pragma unroll
                for (int d = 0; d < NDB; ++d) stg1[crow(r, hi) * 128 + d * 32 + r32] = (unsigned short)(cvtpk(o[d][r] * rs * gs[d], 0.f) & 0xffffu); }
            asm volatile("s_waitcnt lgkmcnt(0)" ::: "memory");
#pragma unroll
            for (int i = 0; i < 8; ++i) { const int row = i * 4 + (lane >> 4), ch = lane & 15; const u32x4 v = *(const ATT_LAS u32x4*)(stg1 + row * 128 + ch * 8);
                __builtin_nontemporal_store(v, (u32x4*)(Y + (yrow0 + row) * 512 + hp * 128 + ch * 8)); }
        }
    }
    asm volatile("s_waitcnt lgkmcnt(0)\n\ts_barrier" ::: "memory");
}

__device__ __forceinline__ void unpack8(const u32x4 v, float (&f)[8]) { f[0] = __uint_as_float(v.x << 16); f[1] = __uint_as_float(v.x & 0xffff0000u); f[2] = __uint_as_float(v.y << 16); f[3] = __uint_as_float(v.y & 0xffff0000u);
    f[4] = __uint_as_float(v.z << 16); f[5] = __uint_as_float(v.z & 0xffff0000u); f[6] = __uint_as_float(v.w << 16); f[7] = __uint_as_float(v.w & 0xffff0000u); }
__device__ __forceinline__ void mixb_rows8(const unsigned short* __restrict__ Z, unsigned short* __restrict__ YB, int row0, int lane) {
    const int t0 = row0 & 4095, w = 2 << (lane >> 4);
    u32x4 v[23];
#pragma unroll
    for (int i = 0; i < 23; ++i) { const int t = t0 - 15 + i; v[i] = (u32x4){0u, 0u, 0u, 0u}; if (t >= 0) v[i] = *(const u32x4*)(Z + (size_t)(row0 - 15 + i) * ZP + 1536 + lane * 8); }
    float s[8];
#pragma unroll
    for (int c = 0; c < 8; ++c) s[c] = 0.f;
#pragma unroll
    for (int i = 0; i < 15; ++i) { if (i >= 16 - w) { float f[8]; unpack8(v[i], f);
#pragma unroll
        for (int c = 0; c < 8; ++c) s[c] += f[c]; } }
#pragma unroll
    for (int r = 0; r < 8; ++r) {
        float f[8]; unpack8(v[15 + r], f);
#pragma unroll
        for (int c = 0; c < 8; ++c) s[c] += f[c];
        const int t = t0 + r, n = (t + 1) < w ? (t + 1) : w; const float inv = 1.0f / (float)n;
        u32x4 o; o.x = cvtpk(s[0] * inv - f[0], s[1] * inv - f[1]); o.y = cvtpk(s[2] * inv - f[2], s[3] * inv - f[3]); o.z = cvtpk(s[4] * inv - f[4], s[5] * inv - f[5]); o.w = cvtpk(s[6] * inv - f[6], s[7] * inv - f[7]);
        __builtin_nontemporal_store(o, (u32x4*)(YB + (size_t)(row0 + r) * 512 + lane * 8));
        float g[8]; const u32x4 old = (w == 2) ? v[14 + r] : (w == 4) ? v[12 + r] : (w == 8) ? v[8 + r] : v[r]; unpack8(old, g);
#pragma unroll
        for (int c = 0; c < 8; ++c) s[c] -= g[c];
    }
}
}
constexpr int NWAVES = 8;
constexpr size_t WS_W = 1536 * MiB;
constexpr size_t LW_WIN = 0;
constexpr size_t LW_WBR = 13 * MiB;
constexpr size_t LW_WOUT = 16 * MiB;
constexpr size_t LW_EGU = 18 * MiB;
constexpr size_t LW_EDN = 83 * MiB;
constexpr size_t LW_RW = 115 * MiB + 512 * 1024;
constexpr size_t LW_STRIDE = 116 * MiB;
constexpr size_t WS_MK_END = WS_W + 4 * LW_STRIDE;
constexpr size_t SM_CS = 7 * MiB;
constexpr size_t SM_BCNT = 8 * MiB;
constexpr int CW_BAR = 4096;

constexpr int RING_OFF = 0, RING_BYTES = 131072;
constexpr int EXTRA_OFF = RING_BYTES, EXTRA_BYTES = 15 * 1024;
constexpr int LDSCTL_OFF = EXTRA_OFF + EXTRA_BYTES, MISC_OFF = LDSCTL_OFF + 64;
constexpr int LDS_BYTES = 147456;

#define GAS __attribute__((address_space(1)))
#define LAS __attribute__((address_space(3)))
typedef float f32x4 __attribute__((ext_vector_type(4)));
typedef unsigned v4u __attribute__((ext_vector_type(4)));
typedef unsigned v2u __attribute__((ext_vector_type(2)));
typedef GAS unsigned gu32;
#define RLX_AGENT __ATOMIC_RELAXED, __HIP_MEMORY_SCOPE_AGENT

#define XB_TMO      128
#define XB_XCNT(j)  (256  + 64 * (j))
#define XB_XSUB(j)  (1280 + 64 * (j))
#define XB_XGEN(j)  (2304 + 64 * (j))
#define XB_TOP      3328
#define XB_TOPGEN   3392
#define XCD_BAR_WORDS 3456
#define XB_SPIN_CAP (1u << 18)
__device__ __forceinline__ unsigned xb_ld(unsigned* p)              { return __hip_atomic_load(p, __ATOMIC_RELAXED, __HIP_MEMORY_SCOPE_AGENT); }
__device__ __forceinline__ unsigned xb_add(unsigned* p, unsigned v) { return __hip_atomic_fetch_add(p, v, __ATOMIC_RELAXED, __HIP_MEMORY_SCOPE_AGENT); }
__device__ __forceinline__ unsigned xb_xcc_id() { return (unsigned)__builtin_amdgcn_s_getreg((3 << 11) | 20) & 0xFu; }
#define XB_SPIN(cond, bar) do { unsigned _sp = 0; while (cond) { __builtin_amdgcn_s_sleep(1); \
    if ((++_sp & 255u) == 0u) { if (xb_ld(&(bar)[XB_TMO])) break; if (_sp > XB_SPIN_CAP) { atomicAdd(&(bar)[XB_TMO], 1u); break; } } } } while (0)
struct XcdBarrier { unsigned* bar; unsigned x; volatile LAS unsigned* st; };
__device__ __forceinline__ XcdBarrier xcd_barrier_post(unsigned* bar, volatile LAS unsigned* st) {
    XcdBarrier b; b.bar = bar; b.x = xb_xcc_id(); b.st = st;
    if (threadIdx.x == 0) (void)xb_add(&bar[XB_XCNT(b.x)], 1u);
    return b;
}
__device__ __forceinline__ void xcd_barrier_complete(unsigned* bar, unsigned x, unsigned& nloc, unsigned& nx) {
    const unsigned G = gridDim.x * gridDim.y * gridDim.z;
    unsigned sum, cnt, mine, sp = 0u;
    for (;;) {
        sum = 0u; cnt = 0u; mine = 0u;
#pragma unroll
        for (unsigned j = 0; j < 16; ++j) { const unsigned c = xb_ld(&bar[XB_XCNT(j)]); sum += c; cnt += (c > 0u) ? 1u : 0u; mine = (j == x) ? c : mine; }
        if (sum == G) break;
        __builtin_amdgcn_s_sleep(1);
        if ((++sp & 255u) == 0u) { if (xb_ld(&bar[XB_TMO])) break; if (sp > XB_SPIN_CAP) { atomicAdd(&bar[XB_TMO], 1u); break; } }
    }
    nloc = mine > 0u ? mine : 1u; nx = cnt > 0u ? cnt : 1u;
}
__device__ __forceinline__ void xcd_barrier(const XcdBarrier& b) {
    asm volatile("s_waitcnt vmcnt(0)" ::: "memory");
    __syncthreads();
    if (threadIdx.x == 0) {
        unsigned* bar = b.bar;
        __builtin_amdgcn_s_waitcnt(0);
        unsigned nloc = b.st[0], nx = b.st[1];
        if (nloc == 0u) { xcd_barrier_complete(bar, b.x, nloc, nx); b.st[0] = nloc; b.st[1] = nx; }
        const unsigned old = xb_add(&bar[XB_XSUB(b.x)], 1u);
        const unsigned gen = old / nloc;
        if (old + 1u == (gen + 1u) * nloc) {
            __builtin_amdgcn_fence(__ATOMIC_RELEASE, "agent");
            asm volatile("s_waitcnt vmcnt(0)" ::: "memory");
            const unsigned og = xb_add(&bar[XB_TOP], 1u);
            const unsigned tg = og / nx;
            if (og + 1u == (tg + 1u) * nx) xb_add(&bar[XB_TOPGEN], 1u);
            else XB_SPIN(xb_ld(&bar[XB_TOPGEN]) == tg, bar);
            __builtin_amdgcn_fence(__ATOMIC_ACQUIRE, "agent");
            xb_add(&bar[XB_XGEN(b.x)], 1u);
            asm volatile("s_waitcnt vmcnt(0)" ::: "memory");
        } else {
            XB_SPIN(xb_ld(&bar[XB_XGEN(b.x)]) == gen, bar);
            __builtin_amdgcn_fence(__ATOMIC_ACQUIRE, "agent");
            asm volatile("s_waitcnt vmcnt(0)" ::: "memory");
        }
    }
    __syncthreads();
}

struct MkArgs { const float* in[24]; float* out; unsigned char* ws; int ph_lo, ph_hi, li, pad; };
struct Frame {
    LAS unsigned char* lds; volatile LAS unsigned* MISC;
    int tid, lane, wave, vcu, G;
};
__device__ __forceinline__ float wave_sum(float v) {
#pragma unroll
    for (int o = 1; o < 64; o <<= 1) v += __shfl_xor(v, o);
    return v;
}
__device__ __forceinline__ unsigned pk2(float lo, float hi) { unsigned r; asm("v_cvt_pk_bf16_f32 %0, %1, %2" : "=v"(r) : "v"(lo), "v"(hi)); return r; }

__device__ __forceinline__ void conv_store(const float (&v)[64], unsigned short* drow) {
#pragma unroll
    for (int c = 0; c < 8; ++c) { v4u o; o.x = pk2(v[8 * c], v[8 * c + 1]); o.y = pk2(v[8 * c + 2], v[8 * c + 3]); o.z = pk2(v[8 * c + 4], v[8 * c + 5]); o.w = pk2(v[8 * c + 6], v[8 * c + 7]); *(v4u*)(drow + 8 * c) = o; }
}
__device__ __forceinline__ void conv_item_fold(const float* __restrict__ w_in_l, const float* __restrict__ pool_w_l, const float* __restrict__ pool_scale_l, unsigned short* __restrict__ WinT, int kb16, int nbj, int lane) {
    const int j = nbj * 64 + lane, g = __builtin_amdgcn_readfirstlane(j >> 7), d = j & 127, k0 = kb16 * 16; float v[16];
#pragma unroll
    for (int i = 0; i < 16; ++i) v[i] = 0.f;
    const float* pw = pool_w_l + (size_t)g * 128 * 128 + d;
    const float* wbase = w_in_l + (size_t)k0 * DIN + C_UB + g * 128;
#pragma unroll 4
    for (int c = 0; c < 128; ++c) { const float p = pw[(size_t)c * 128];
#pragma unroll
        for (int i = 0; i < 16; ++i) v[i] += wbase[(size_t)i * DIN + c] * p; }
    const float ps = pool_scale_l[j];
    unsigned short* drow = WinT + (size_t)(C_UB + j) * DM + k0;
#pragma unroll
    for (int c = 0; c < 2; ++c) { v4u o; o.x = pk2(v[8 * c] * ps, v[8 * c + 1] * ps); o.y = pk2(v[8 * c + 2] * ps, v[8 * c + 3] * ps); o.z = pk2(v[8 * c + 4] * ps, v[8 * c + 5] * ps); o.w = pk2(v[8 * c + 6] * ps, v[8 * c + 7] * ps); *(v4u*)(drow + 8 * c) = o; }
}
__device__ __forceinline__ void conv_item_router(const float* __restrict__ rw_l, unsigned short* __restrict__ hi, unsigned short* __restrict__ lo, int kb, int lane) {
    const int k0 = kb * 64; float v[64], w[64];
#pragma unroll
    for (int i = 0; i < 64; ++i) { const float x = rw_l[(size_t)(k0 + i) * 64 + lane]; const float h = __uint_as_float(pk2(x, 0.f) << 16); v[i] = h; w[i] = x - h; }
    conv_store(v, hi + (size_t)lane * DM + k0); conv_store(w, lo + (size_t)lane * DM + k0);
}
constexpr int IT_RW = 16;
constexpr int WT_W256 = 16 * 24, WT_BR = 8 * 4, WT_WOUT = 16 * 4, WT_EGU = 64 * 16 * 2, WT_EDN = 64 * 4 * 4, WT_SGU = 16 * 2, WT_SDN = 4 * 4;
constexpr int WT_LAYER = WT_W256 + 3 * WT_BR + WT_WOUT + WT_EGU + WT_EDN + WT_SGU + WT_SDN;
struct ConvTile { const float* src; unsigned short* dst; int N, K, n0, perm; };
__device__ __forceinline__ ConvTile conv_tile_decode(const MkArgs& a, unsigned char* ws, int it) {
    const int l = it / WT_LAYER; int r = it % WT_LAYER; unsigned char* lw = ws + WS_W + (size_t)l * LW_STRIDE;
    ConvTile t; const float* W; unsigned short* WT; int kb, nb; t.perm = 0;
    if (r < WT_W256) { kb = r % 16; nb = r / 16; if (nb >= 6) nb += 2; W = a.in[1] + (size_t)l * DM * DIN; t.K = DM; t.N = DIN; WT = (unsigned short*)(lw + LW_WIN); }
    else if ((r -= WT_W256) < 3 * WT_BR) { const int br = r / WT_BR, q = r % WT_BR; W = a.in[10] + (size_t)l * 512 * DM; if (br == 1) W = a.in[11] + (size_t)l * 512 * DM; if (br == 2) W = a.in[12] + (size_t)l * 512 * DM; t.K = 512; t.N = DM; WT = (unsigned short*)(lw + LW_WBR + (size_t)br * MiB); kb = q % 8; nb = q / 8; }
    else if ((r -= 3 * WT_BR) < WT_WOUT) { W = a.in[13] + (size_t)l * DM * DM; t.K = DM; t.N = DM; WT = (unsigned short*)(lw + LW_WOUT); kb = r % 16; nb = r / 16; }
    else if ((r -= WT_WOUT) < WT_EGU) { const int e = r / 32, q = r % 32; W = a.in[18] + ((size_t)l * NEXP + e) * DM * 512; t.K = DM; t.N = 512; WT = (unsigned short*)(lw + LW_EGU) + (size_t)e * 512 * DM; kb = q % 16; nb = q / 16; t.perm = 1; }
    else if ((r -= WT_EGU) < WT_EDN) { const int e = r / 16, q = r % 16; W = a.in[19] + ((size_t)l * NEXP + e) * EDIM * DM; t.K = EDIM; t.N = DM; WT = (unsigned short*)(lw + LW_EDN) + (size_t)e * DM * EDIM; kb = q % 4; nb = q / 4; }
    else if ((r -= WT_EDN) < WT_SGU) { W = a.in[20] + (size_t)l * DM * 512; t.K = DM; t.N = 512; WT = (unsigned short*)(lw + LW_EGU) + (size_t)NEXP * 512 * DM; kb = r % 16; nb = r / 16; t.perm = 1; }
    else { r -= WT_SGU; W = a.in[21] + (size_t)l * EDIM * DM; t.K = EDIM; t.N = DM; WT = (unsigned short*)(lw + LW_EDN) + (size_t)NEXP * DM * EDIM; kb = r % 4; nb = r / 4; }
    t.n0 = nb * 256; t.src = W + (size_t)(kb * 64) * t.N + t.n0; t.dst = WT + kb * 64;
    return t;
}
constexpr int CONV_FILL_NF = 12, CONV_FILL_N = 128 * CONV_FILL_NF;
__device__ __forceinline__ int conv_map_p0(int j, int fn) { if (j < WT_LAYER) return j; const int q = j - WT_LAYER, per = WT_LAYER - fn, l = q / per; return (1 + l) * WT_LAYER + fn + (q - l * per); }
template <bool P0MAP>
__device__ __forceinline__ void conv_wg_loop(const Frame& F, const MkArgs& a, unsigned char* ws, int first, int stride, int count, int fn) {
    constexpr int TP = 144;
    const int lane = F.lane, w = F.wave;
#define CONV_MAP(j) (P0MAP ? conv_map_p0((j), fn) : (j))
#define CONV_LOAD(v, t) do { _Pragma("unroll") for (int i_ = 0; i_ < 8; ++i_) v[i_] = __builtin_nontemporal_load((const f32x4*)((t).src + (size_t)(8 * w + i_) * (t).N) + lane); } while (0)
#define CONV_TO_LDS(v, T) do { _Pragma("unroll") for (int j_ = 0; j_ < 4; ++j_) { v4u o_; o_.x = pk2(v[0][j_], v[1][j_]); o_.y = pk2(v[2][j_], v[3][j_]); o_.z = pk2(v[4][j_], v[5][j_]); o_.w = pk2(v[6][j_], v[7][j_]); \
        *(LAS v4u*)((T) + (4 * lane + j_) * TP + 16 * w) = o_; } } while (0)
#define CONV_STORE(tc, T) do { _Pragma("unroll") for (int i_ = 0; i_ < 4; ++i_) { const int nr_ = 32 * w + 8 * i_ + (lane >> 3), c_ = lane & 7; const v4u o_ = *(const LAS v4u*)((T) + nr_ * TP + 16 * c_); \
        const int n_ = (tc).n0 + nr_; int drow_ = n_; if ((tc).perm) { const int half_ = n_ >> 8, j_ = n_ & 255; drow_ = 256 * (j_ >> 7) + 128 * half_ + (j_ & 127); } \
        __builtin_nontemporal_store(o_, (v4u*)((tc).dst + (size_t)drow_ * (tc).K + 8 * c_)); } } while (0)
#define CONV_BAR() asm volatile("s_waitcnt lgkmcnt(0)\n\ts_barrier" ::: "memory")
#define CONV_STEADY() do { \
        CONV_TO_LDS(va, T0); CONV_BAR(); { const ConvTile tc_ = ta; ta = conv_tile_decode(a, ws, CONV_MAP(it + 2 * stride)); CONV_LOAD(va, ta); CONV_STORE(tc_, T0); } \
        CONV_TO_LDS(vb, T1); CONV_BAR(); { const ConvTile tc_ = tb; tb = conv_tile_decode(a, ws, CONV_MAP(it + 3 * stride)); CONV_LOAD(vb, tb); CONV_STORE(tc_, T1); } \
        it += 2 * stride; } while (0)
    int it = first; if (it >= count) return;
    ConvTile ta = conv_tile_decode(a, ws, CONV_MAP(it)), tb = ta; f32x4 va[8], vb[8];
    CONV_LOAD(va, ta);
    bool hb = it + stride < count;
    if (hb) { tb = conv_tile_decode(a, ws, CONV_MAP(it + stride)); CONV_LOAD(vb, tb); }
    LAS unsigned char* T0 = F.lds; LAS unsigned char* T1 = F.lds + 256 * TP;
    if (it + 3 * stride < count) {
        CONV_STEADY();
#pragma clang loop unroll(disable)
        while (it + 3 * stride < count) CONV_STEADY();
    }
    hb = it + stride < count;
    for (;;) {
        CONV_TO_LDS(va, T0);
        __syncthreads();
        const ConvTile tca = ta; const int ia2 = it + 2 * stride; const bool ha = ia2 < count;
        if (ha) { ta = conv_tile_decode(a, ws, CONV_MAP(ia2)); CONV_LOAD(va, ta); }
        CONV_STORE(tca, T0);
        if (!hb) break;
        CONV_TO_LDS(vb, T1);
        __syncthreads();
        const ConvTile tcb = tb; const int ib2 = it + 3 * stride; hb = ib2 < count;
        if (hb) { tb = conv_tile_decode(a, ws, CONV_MAP(ib2)); CONV_LOAD(vb, tb); }
        CONV_STORE(tcb, T1);
        if (!ha) break;
        it = ia2;
    }
    __syncthreads();
#undef CONV_MAP
#undef CONV_LOAD
#undef CONV_TO_LDS
#undef CONV_STORE
#undef CONV_BAR
#undef CONV_STEADY
}
__device__ __forceinline__ void p0_prologue(const Frame& F, const MkArgs& a) {
    const int gw = F.vcu * NWAVES + F.wave, NGW = F.G * NWAVES, lane = F.lane;
    unsigned char* ws = a.ws;
    {
    const int fn = (F.G == 256) ? CONV_FILL_N : 0;
    conv_wg_loop<true>(F, a, ws, F.vcu, F.G, WT_LAYER + (DEPTH - 1) * (WT_LAYER - fn), fn);
    for (int it = gw; it < DEPTH * IT_RW; it += NGW) { const int l = it / IT_RW, r = it % IT_RW; unsigned char* lw = ws + WS_W + (size_t)l * LW_STRIDE;
        conv_item_router(a.in[16] + (size_t)l * DM * NEXP, (unsigned short*)(lw + LW_RW), (unsigned short*)(lw + LW_RW) + (size_t)NEXP * DM, r, lane); }
    }
    {
    for (int it = gw; it < DEPTH * 64 * 8; it += NGW) { const int l = it >> 9, kb16 = (it >> 3) & 63, nbj = it & 7;
        conv_item_fold(a.in[1] + (size_t)l * DM * DIN, a.in[3] + (size_t)l * 4 * 128 * 128, a.in[4] + (size_t)l * 512, (unsigned short*)(ws + WS_W + (size_t)l * LW_STRIDE + LW_WIN), kb16, nbj, lane); }
    }
    {
    unsigned short* xb = (unsigned short*)(ws + WS_XB);
    for (int m = gw; m < NTOK; m += NGW) { const f32x4* xr = (const f32x4*)(a.in[0] + (size_t)m * DM) + lane; v2u* bo = (v2u*)(xb + (size_t)m * DM) + lane;
        f32x4 v[4];
#pragma unroll
        for (int j = 0; j < 4; ++j) v[j] = xr[64 * j];
#pragma unroll
        for (int j = 0; j < 4; ++j) { v2u o; o.x = pk2(v[j].x, v[j].y); o.y = pk2(v[j].z, v[j].w); bo[64 * j] = o; } }
    float* cs = (float*)(ws + WS_SMALL + SM_CS);
    for (int i = gw * 64 + lane; i < SEQ * 8; i += NGW * 64) { const int t = i >> 3, ii = i & 7; const float inv = powf(500000.0f, -(float)(2 * ii) / 16.0f); const float ang = (float)t * inv; cs[t * 16 + ii] = cosf(ang); cs[t * 16 + 8 + ii] = sinf(ang); }
    if (gw < DEPTH) { const int l = gw; const float s1 = wave_sum(a.in[5][l * 64 + lane] * a.in[6][l * 64 + lane]), s2 = wave_sum(a.in[7][l * 64 + lane] * a.in[8][l * 64 + lane]);
        if (lane == 0) ((float*)(ws + WS_SMALL + SM_LAM))[l] = expf(s1) - expf(s2); }
    }
}

__device__ __forceinline__ void ln1_router_block(const Frame& F, int tb, unsigned short* xb, const float* __restrict__ g, const float* __restrict__ bta,
                                                 const unsigned short* __restrict__ rwhi, const unsigned short* __restrict__ rwlo, const float* __restrict__ rbias,
                                                 int* __restrict__ idx, float* __restrict__ wts, int* __restrict__ rank, int* __restrict__ bcnt) {
    typedef short bf16x8 __attribute__((ext_vector_type(8)));
    LAS float* stats = (LAS float*)(F.lds);
    LAS float* lgp = (LAS float*)(F.lds + 1024);
    LAS float* scs = (LAS float*)(F.lds + 1024 + 16384);
    LAS float* chs = scs + 64 * 65;
    LAS int* hist = (LAS int*)(chs + 64 * 65);
    LAS float* gl = (LAS float*)(F.lds + 61440);
    LAS float* bl = gl + 1024;
    const int lane = F.lane, w = F.wave, tid = F.tid;
    if (tid < 64) hist[tid] = 0;
    for (int i = tid; i < DM; i += NWAVES * 64) { gl[i] = g[i]; bl[i] = bta[i]; }
    for (int rr = 0; rr < 8; rr += 2) { const int row = tb * 64 + w * 8 + rr; const v4u* xr = (const v4u*)(xb + (size_t)row * DM) + lane; float v[2][16]; float s0 = 0.f, s1 = 0.f;
        { const v4u a0 = xr[0], a1 = xr[64], c0 = xr[128], c1 = xr[192];
#define UNP8(dst, o, q) do { dst[o] = __uint_as_float(q.x << 16); dst[o + 1] = __uint_as_float(q.x & 0xffff0000u); dst[o + 2] = __uint_as_float(q.y << 16); dst[o + 3] = __uint_as_float(q.y & 0xffff0000u); \
            dst[o + 4] = __uint_as_float(q.z << 16); dst[o + 5] = __uint_as_float(q.z & 0xffff0000u); dst[o + 6] = __uint_as_float(q.w << 16); dst[o + 7] = __uint_as_float(q.w & 0xffff0000u); } while (0)
          UNP8(v[0], 0, a0); UNP8(v[0], 8, a1); UNP8(v[1], 0, c0); UNP8(v[1], 8, c1);
#undef UNP8
        }
#pragma unroll
        for (int j = 0; j < 16; ++j) { s0 += v[0][j]; s1 += v[1][j]; }
        const float m0 = wave_sum(s0) * (1.f / DM), m1 = wave_sum(s1) * (1.f / DM); float q0 = 0.f, q1 = 0.f;
#pragma unroll
        for (int j = 0; j < 16; ++j) { const float d0 = v[0][j] - m0, d1 = v[1][j] - m1; q0 += d0 * d0; q1 += d1 * d1; }
        const float r0 = rsqrtf(wave_sum(q0) * (1.f / DM) + LN_EPS), r1 = rsqrtf(wave_sum(q1) * (1.f / DM) + LN_EPS);
        if (lane == 0) { stats[(w * 8 + rr) * 2] = m0; stats[(w * 8 + rr) * 2 + 1] = r0; stats[(w * 8 + rr) * 2 + 2] = m1; stats[(w * 8 + rr) * 2 + 3] = r1; } }
    __syncthreads();
    const int tq = w & 3, kh = w >> 2, trow = lane & 15, kg = lane >> 4;
    const int row = tb * 64 + tq * 16 + trow;
    const float mean = stats[(tq * 16 + trow) * 2], rstd = stats[(tq * 16 + trow) * 2 + 1];
    f32x4 acc[4];
#pragma unroll
    for (int nb = 0; nb < 4; ++nb) acc[nb] = (f32x4){0.f, 0.f, 0.f, 0.f};
#pragma clang loop unroll(disable)
    for (int sb = 0; sb < 2; ++sb) {
        v4u xr8[8]; f32x4 xa[8][2];
#pragma unroll
        for (int s = 0; s < 8; ++s) xr8[s] = *(const v4u*)(xb + (size_t)row * DM + kh * 512 + (sb * 8 + s) * 32 + kg * 8);
#pragma unroll
        for (int s = 0; s < 8; ++s) { const v4u q = xr8[s]; xa[s][0] = (f32x4){__uint_as_float(q.x << 16), __uint_as_float(q.x & 0xffff0000u), __uint_as_float(q.y << 16), __uint_as_float(q.y & 0xffff0000u)};
            xa[s][1] = (f32x4){__uint_as_float(q.z << 16), __uint_as_float(q.z & 0xffff0000u), __uint_as_float(q.w << 16), __uint_as_float(q.w & 0xffff0000u)}; }
        bf16x8 wc[4][2], wn[4][2];
        { const int k0 = kh * 512 + (sb * 8) * 32 + kg * 8;
#pragma unroll
          for (int nb = 0; nb < 4; ++nb) { const size_t wo = (size_t)(nb * 16 + trow) * DM + k0; wc[nb][0] = *(const bf16x8*)(rwhi + wo); } }
#pragma unroll
        for (int s = 0; s < 8; ++s) {
            const int k0 = kh * 512 + (sb * 8 + s) * 32 + kg * 8;
            if (s < 7) {
#pragma unroll
                for (int nb = 0; nb < 4; ++nb) { const size_t wo = (size_t)(nb * 16 + trow) * DM + k0 + 32; wn[nb][0] = *(const bf16x8*)(rwhi + wo); } }
            asm volatile("" ::: "memory");
            const f32x4 g0 = *(const LAS f32x4*)(gl + k0), g1 = *(const LAS f32x4*)(gl + k0 + 4), b0 = *(const LAS f32x4*)(bl + k0), b1 = *(const LAS f32x4*)(bl + k0 + 4);
            const f32x4 y0 = (xa[s][0] - mean) * rstd * g0 + b0, y1 = (xa[s][1] - mean) * rstd * g1 + b1;
            v4u hb; hb.x = pk2(y0.x, y0.y); hb.y = pk2(y0.z, y0.w); hb.z = pk2(y1.x, y1.y); hb.w = pk2(y1.z, y1.w);
            __builtin_nontemporal_store(hb, (v4u*)(xb + (size_t)row * DM + k0));
            v4u lb; lb.x = pk2(y0.x - __uint_as_float(hb.x << 16), y0.y - __uint_as_float(hb.x & 0xffff0000u)); lb.y = pk2(y0.z - __uint_as_float(hb.y << 16), y0.w - __uint_as_float(hb.y & 0xffff0000u));
            lb.z = pk2(y1.x - __uint_as_float(hb.z << 16), y1.y - __uint_as_float(hb.z & 0xffff0000u)); lb.w = pk2(y1.z - __uint_as_float(hb.w << 16), y1.w - __uint_as_float(hb.w & 0xffff0000u));
            const bf16x8 xh = __builtin_bit_cast(bf16x8, hb), xl = __builtin_bit_cast(bf16x8, lb);
#pragma unroll
            for (int nb = 0; nb < 4; ++nb) acc[nb] = __builtin_amdgcn_mfma_f32_16x16x32_bf16(wc[nb][0], xh, acc[nb], 0, 0, 0);
#pragma unroll
            for (int nb = 0; nb < 4; ++nb) acc[nb] = __builtin_amdgcn_mfma_f32_16x16x32_bf16(wc[nb][0], xl, acc[nb], 0, 0, 0);
            asm volatile("" ::: "memory");
#pragma unroll
            for (int nb = 0; nb < 4; ++nb) wc[nb][0] = wn[nb][0];
        }
    }
    if (kh == 1) {
#pragma unroll
        for (int nb = 0; nb < 4; ++nb)
#pragma unroll
            for (int r = 0; r < 4; ++r) lgp[(tq * 16 + trow) * 64 + nb * 16 + kg * 4 + r] = acc[nb][r];
    }
    __syncthreads();
    if (kh == 0) {
#pragma unroll
        for (int nb = 0; nb < 4; ++nb)
#pragma unroll
            for (int r = 0; r < 4; ++r) { const int e = nb * 16 + kg * 4 + r; const float lgt = acc[nb][r] + lgp[(tq * 16 + trow) * 64 + e]; const float sg = 1.f / (1.f + expf(-lgt));
                scs[(tq * 16 + trow) * 65 + e] = sg; chs[(tq * 16 + trow) * 65 + e] = sg + rbias[e]; }
    }
    __syncthreads();
    {
        const int tl = lane >> 3, gI = lane & 7, tloc = w * 8 + tl, tok = tb * 64 + tloc;
        float c[8], s[8];
#pragma unroll
        for (int j = 0; j < 8; ++j) { c[j] = chs[tloc * 65 + gI * 8 + j]; s[j] = scs[tloc * 65 + gI * 8 + j]; }
        float a = -INFINITY, b2 = -INFINITY;
#pragma unroll
        for (int j = 0; j < 8; ++j) { if (c[j] > a) { b2 = a; a = c[j]; } else if (c[j] > b2) b2 = c[j]; }
        const float gsum = a + b2; int cnt = 0;
#pragma unroll
        for (int d = 1; d < 8; ++d) { const int og = (gI + d) & 7; const float o = __shfl(gsum, (lane & ~7) | og); cnt += (o > gsum || (o == gsum && og < gI)) ? 1 : 0; }
        if (cnt >= 4) {
#pragma unroll
            for (int j = 0; j < 8; ++j) c[j] = -INFINITY; }
        int id[8]; float wv[8]; float sum = 0.f;
#pragma unroll
        for (int n = 0; n < 8; ++n) {
            float bv = c[0]; int be = 0;
#pragma unroll
            for (int j = 1; j < 8; ++j) { if (c[j] > bv) { bv = c[j]; be = j; } }
            be += gI * 8;
#pragma unroll
            for (int mk = 1; mk < 8; mk <<= 1) { const float v2 = __shfl_xor(bv, mk); const int e2 = __shfl_xor(be, mk); const bool tk = (v2 > bv) || (v2 == bv && e2 < be); bv = tk ? v2 : bv; be = tk ? e2 : be; }
            const bool own = (be >> 3) == gI; float sv = 0.f;
#pragma unroll
            for (int j = 0; j < 8; ++j) { const bool hit = own && ((be & 7) == j); sv = hit ? s[j] : sv; c[j] = hit ? -INFINITY : c[j]; }
            sv = __shfl(sv, (lane & ~7) | (be >> 3));
            id[n] = be; wv[n] = sv; sum += sv;
        }
        const float rs = ROUTED_SCALE / sum; int myid = id[0]; float myw = wv[0];
#pragma unroll
        for (int n = 1; n < 8; ++n) { myid = (gI == n) ? id[n] : myid; myw = (gI == n) ? wv[n] : myw; }
        idx[tok * 8 + gI] = myid; wts[tok * 8 + gI] = myw * rs;
        rank[tok * 8 + gI] = __hip_atomic_fetch_add((LAS int*)&hist[myid], 1, __ATOMIC_RELAXED, __HIP_MEMORY_SCOPE_WORKGROUP);
    }
    __syncthreads();
    if (tid < 64) bcnt[tb * 64 + tid] = hist[tid];
    __syncthreads();
}

__device__ __forceinline__ void scatter_block(const Frame& F, int tb, const int* __restrict__ bcnt, const int* __restrict__ idx, const int* __restrict__ rank, int* __restrict__ pos, int* __restrict__ rowtok,
                                              int* __restrict__ off_g, int* __restrict__ tile_expert, int* __restrict__ ntiles, bool writer) {
    LAS int* tot = (LAS int*)(F.lds);
    LAS int* pre = tot + 64;
    LAS int* off = pre + 64;
    const int tid = F.tid;
    { LAS int* part = off + 80;
      const int e = tid & 63, pt = tid >> 6; int t = 0, p = 0;
#pragma unroll 8
      for (int b = pt * 32; b < pt * 32 + 32; ++b) { const int c = bcnt[b * 64 + e]; t += c; p += (b < tb) ? c : 0; }
      part[pt * 64 + e] = t; part[512 + pt * 64 + e] = p; }
    __syncthreads();
    if (tid < 64) { int t = 0, p = 0;
#pragma unroll
      for (int pt = 0; pt < 8; ++pt) { t += (off + 80)[pt * 64 + tid]; p += (off + 80)[512 + pt * 64 + tid]; } tot[tid] = t; pre[tid] = p; }
    __syncthreads();
    if (tid == 0) { int o = 0; for (int e = 0; e < NEXP; ++e) { off[e] = o; o += ((tot[e] + 255) >> 8) * 256; } off[NEXP] = o; }
    __syncthreads();
    if (writer) { const int ntr = off[NEXP] >> 8;
        if (tid <= NEXP) off_g[tid] = off[tid];
        for (int t = tid; t < ntr + NTOK / 256; t += NWAVES * 64) { int e = NEXP; if (t < ntr) { e = 0; while (off[e + 1] <= t * 256) ++e; } tile_expert[t] = e; }
        if (tid == 0) *ntiles = ntr + NTOK / 256; }
    { const int i = tb * 512 + tid; const int e = idx[i]; const int p = off[e] + pre[e] + rank[i]; pos[i] = p; rowtok[p] = i >> 3; }
    if (tid < 64) rowtok[off[NEXP] + tb * 64 + tid] = tb * 64 + tid;
    __syncthreads();
}

template <int NR>
__device__ __forceinline__ void combine_rows(const int (&rows)[NR], int lane, float* __restrict__ outf, unsigned short* xb, const unsigned short* __restrict__ YE, const int* __restrict__ pos, const float* __restrict__ wts,
                                             int shared_base, const float* __restrict__ g, const float* __restrict__ bta, float alpha) {
    f32x4 v[NR][4]; float s[NR];
    int pr[NR][9]; float wr[NR][9];
#pragma unroll
    for (int r = 0; r < NR; ++r) { s[r] = 0.f;
#pragma unroll
        for (int k = 0; k < 8; ++k) { pr[r][k] = pos[rows[r] * 8 + k]; wr[r][k] = wts[rows[r] * 8 + k]; }
        pr[r][8] = shared_base + rows[r]; wr[r][8] = 1.f; }
#pragma unroll
    for (int j = 0; j < 4; ++j) {
        f32x4 y[NR]; v2u xq[NR];
#pragma unroll
        for (int r = 0; r < NR; ++r) { y[r] = (f32x4){0.f, 0.f, 0.f, 0.f}; xq[r] = ((const v2u*)(xb + (size_t)rows[r] * DM))[64 * j + lane]; }
#pragma unroll
        for (int k = 0; k < 9; ++k)
#pragma unroll
            for (int r = 0; r < NR; ++r) { const v2u u = ((const v2u*)(YE + (size_t)pr[r][k] * DM))[64 * j + lane];
                y[r].x += wr[r][k] * __uint_as_float(u.x << 16); y[r].y += wr[r][k] * __uint_as_float(u.x & 0xffff0000u); y[r].z += wr[r][k] * __uint_as_float(u.y << 16); y[r].w += wr[r][k] * __uint_as_float(u.y & 0xffff0000u); }
#pragma unroll
        for (int r = 0; r < NR; ++r) { const v2u q = xq[r]; const f32x4 x = {__uint_as_float(q.x << 16), __uint_as_float(q.x & 0xffff0000u), __uint_as_float(q.y << 16), __uint_as_float(q.y & 0xffff0000u)};
            v[r][j] = x * alpha + y[r]; s[r] += (v[r][j].x + v[r][j].y) + (v[r][j].z + v[r][j].w); }
    }
    float mean[NR], rstd[NR];
#pragma unroll
    for (int r = 0; r < NR; ++r) mean[r] = wave_sum(s[r]) * (1.f / DM);
#pragma unroll
    for (int r = 0; r < NR; ++r) { float q = 0.f;
#pragma unroll
        for (int j = 0; j < 4; ++j) { v[r][j] = v[r][j] - mean[r]; q += (v[r][j].x * v[r][j].x + v[r][j].y * v[r][j].y) + (v[r][j].z * v[r][j].z + v[r][j].w * v[r][j].w); }
        rstd[r] = q; }
#pragma unroll
    for (int r = 0; r < NR; ++r) rstd[r] = rsqrtf(wave_sum(rstd[r]) * (1.f / DM) + LN_EPS);
#pragma unroll
    for (int j = 0; j < 4; ++j) { const f32x4 gg = ((const f32x4*)g)[64 * j + lane], bb = ((const f32x4*)bta)[64 * j + lane];
#pragma unroll
        for (int r = 0; r < NR; ++r) { const f32x4 o = v[r][j] * rstd[r] * gg + bb;
            if (outf) __builtin_nontemporal_store(o, (f32x4*)(outf + (size_t)rows[r] * DM) + 64 * j + lane);
            v2u ob; ob.x = pk2(o.x, o.y); ob.y = pk2(o.z, o.w); __builtin_nontemporal_store(ob, (v2u*)(xb + (size_t)rows[r] * DM) + 64 * j + lane); } }
}

__device__ __forceinline__ int group_setup(const Frame& F, int c, int NT, const int* __restrict__ tile_expert, const int* __restrict__ ntiles_p, const int* __restrict__ rowtok, bool gather) {
    LAS int* ul = (LAS int*)(F.lds + EXTRA_OFF);
    LAS int* rt = (LAS int*)(F.lds + EXTRA_OFF + 256);
    const int total = (*ntiles_p) * NT;
    int nu = c < total ? (total - c + F.G - 1) / F.G : 0; if (nu > (gather ? 8 : 16)) nu = gather ? 8 : 16;
    if (F.tid < nu) { const int L = F.tid * F.G + c; const int tile = L / NT; ul[4 * F.tid] = tile; ul[4 * F.tid + 1] = L % NT; ul[4 * F.tid + 2] = tile_expert[tile]; ul[4 * F.tid + 3] = 0; }
    if (gather) { for (int i = F.tid; i < nu * 256; i += NWAVES * 64) { const int u = i >> 8; const int L = u * F.G + c; rt[i] = rowtok[(L / NT) * 256 + (i & 255)]; } }
    __syncthreads();
    return nu;
}

constexpr int PH_PER_LAYER = 9, N_PHASES = 1 + DEPTH * PH_PER_LAYER;
__global__ void __launch_bounds__(NWAVES * 64, 2) mk_fwd(MkArgs args) {
    extern __shared__ __attribute__((aligned(16))) unsigned char lds_raw[];
    Frame F;
    F.lds = (LAS unsigned char*)lds_raw;
    F.MISC = (volatile LAS unsigned*)(F.lds + MISC_OFF);
    F.tid = threadIdx.x; F.lane = F.tid & 63; F.wave = __builtin_amdgcn_readfirstlane(F.tid >> 6);
    F.G = gridDim.x; { const int bx = blockIdx.x; F.vcu = (F.G % 8 == 0) ? (bx % 8) * (F.G / 8) + bx / 8 : bx; }
    unsigned char* ws = args.ws;
    gu32* ctl = (gu32*)(ws + WS_CTL);
    for (int u = F.tid; u < (LDS_BYTES - LDSCTL_OFF) / 4; u += NWAVES * 64) ((LAS unsigned*)(F.lds + LDSCTL_OFF))[u] = 0u;
    __syncthreads();
    XcdBarrier bar = xcd_barrier_post((unsigned*)(ctl + CW_BAR) + args.li * 4096, F.MISC + 8);
    const int lo = args.ph_lo, hi = args.ph_hi;
#define IN(k) (lo <= (k) && (k) < hi)
#define RELAUNDER() do { int t_ = threadIdx.x; asm volatile("" : "+v"(t_)); F.tid = t_; F.lane = t_ & 63; } while (0)
#define SEAM(k) do { if (IN(k) && IN((k) + 1)) xcd_barrier(bar); } while (0)
#define P_IDX ((int*)(wsl + WS_SMALL + SM_IDX))
#define P_WTS ((float*)(wsl + WS_SMALL + SM_WTS))
#define P_RANK ((int*)(wsl + WS_SMALL + SM_RANK))
#define P_POS ((int*)(wsl + WS_SMALL + SM_POS))
#define P_ROWTOK ((int*)(wsl + WS_SMALL + SM_ROWTOK))
#define P_OFF ((int*)(wsl + WS_SMALL + SM_OFF))
#define P_TILE ((int*)(wsl + WS_SMALL + SM_TILE))
#define P_NT ((int*)(wsl + WS_SMALL + SM_NT))
#define P_LAM ((const float*)(wsl + WS_SMALL + SM_LAM))
#define P_CS ((const float*)(wsl + WS_SMALL + SM_CS))
#define P_BCNT ((int*)(wsl + WS_SMALL + SM_BCNT))
#define P_XB ((unsigned short*)(wsl + WS_XB))
#define P_Z ((unsigned short*)(wsl + WS_Z))
#define P_YA ((unsigned short*)(wsl + WS_YA))
#define P_YB ((unsigned short*)(wsl + WS_YB))
#define P_YC ((unsigned short*)(wsl + WS_YC))
#define P_MF ((float*)(wsl + WS_MF))
#define P_MERGED ((unsigned short*)(wsl + WS_MERGED))
#define P_HID ((unsigned short*)(wsl + WS_HID))
#define P_YE ((unsigned short*)(wsl + WS_YE))
    unsigned char* wsl = ws; float* xf = args.out;
    const float alpha = 1.681792830507429f;
    const int gw = F.vcu * NWAVES + F.wave, NGW = F.G * NWAVES;

    if (IN(0)) { RELAUNDER(); p0_prologue(F, args); SEAM(0); }

    for (int l = 0; l < DEPTH; ++l) {
        const int pb = 1 + l * PH_PER_LAYER;

        if (IN(pb + 0)) {
            RELAUNDER();
            pg8::SchedDense S{(const char*)P_XB, (const char*)(wsl + WS_W + (size_t)l * LW_STRIDE + LW_WIN), NTOK / 256, DIN / 256, F.G, (int)blockIdx.x, DM, 0};
            pg8::EpiInproj E{P_Z, P_CS};
            pg8::gemm_phase<pg8::EpiInproj, pg8::SchedDense, true>(F.lds + RING_OFF, DM, S, E);
            if (l + 1 < DEPTH && F.G == 256 && (int)blockIdx.x >= 128) { __syncthreads(); conv_wg_loop<false>(F, args, wsl, (l + 1) * WT_LAYER + ((int)blockIdx.x - 128), 128, (l + 1) * WT_LAYER + CONV_FILL_N, 0); }
            SEAM(pb + 0);
        }
        if (IN(pb + 1)) {
            RELAUNDER();
            const float lambda_init = 0.8f - 0.6f * expf(-0.3f * (float)l);
            const float lam = P_LAM[l] + lambda_init, oml = 1.0f - lambda_init;
            for (int p = F.vcu; p < 256; p += F.G) { const int bh = p >> 4, s = p & 15;
                att::attn_unit<1>(F.lds, P_Z, bh >> 2, bh & 3, s, nullptr, lam, oml, args.in[9] + l * 128, P_YC);
                att::attn_unit<1>(F.lds, P_Z, bh >> 2, bh & 3, 31 - s, nullptr, lam, oml, args.in[9] + l * 128, P_YC); }
            for (int u = F.vcu; u < 512; u += F.G) { const int bh = u >> 5, qb = u & 31;
                att::attn_unit<0>(F.lds, P_Z, bh >> 2, bh & 3, qb, args.in[2] + (size_t)l * 8 * RELN, 0.f, 0.f, nullptr, P_YA); }
            { int tl_ = threadIdx.x; asm volatile("" : "+v"(tl_)); for (int m = gw; m < NTOK / 8; m += NGW) att::mixb_rows8(P_Z, P_YB, m * 8, tl_ & 63); }
            SEAM(pb + 1);
        }
        if (IN(pb + 2)) {
            RELAUNDER();
            pg8::SchedBranchHN S{(const char*)P_YA, (const char*)(wsl + WS_W + (size_t)l * LW_STRIDE + LW_WBR), (size_t)(WS_YB - WS_YA), (size_t)MiB, F.G, F.vcu, 512};
            pg8::EpiBranchHN E{P_MERGED, P_Z};
            pg8::gemm_phase_hn<pg8::EpiBranchHN, pg8::SchedBranchHN>(F.lds + RING_OFF, 512, S, E);
            SEAM(pb + 2);
        }
        if (IN(pb + 3)) {
            RELAUNDER();
            pg8::SchedDense S{(const char*)P_MERGED, (const char*)(wsl + WS_W + (size_t)l * LW_STRIDE + LW_WOUT), NTOK / 256, DM / 256, F.G, (int)blockIdx.x, DM, 0};
            pg8::EpiWout E{P_XB, alpha, 0};
            pg8::gemm_phase<pg8::EpiWout, pg8::SchedDense, true>(F.lds + RING_OFF, DM, S, E);
            SEAM(pb + 3);
        }
        if (IN(pb + 4)) {
            RELAUNDER();
            for (int bb = blockIdx.x; bb < 256; bb += F.G) for (int i = bb * 512 + F.tid; i < MAXROWS; i += 256 * 512) P_ROWTOK[i] = 0;
            for (int tb = blockIdx.x; tb < 256; tb += F.G)
                ln1_router_block(F, tb, P_XB, args.in[14] + l * DM, args.in[15] + l * DM, (const unsigned short*)(wsl + WS_W + (size_t)l * LW_STRIDE + LW_RW), (const unsigned short*)(wsl + WS_W + (size_t)l * LW_STRIDE + LW_RW) + (size_t)NEXP * DM, args.in[17] + l * NEXP, P_IDX, P_WTS, P_RANK, P_BCNT);
            SEAM(pb + 4);
        }
        if (IN(pb + 5)) {
            RELAUNDER();
            for (int tb = blockIdx.x; tb < 256; tb += F.G) scatter_block(F, tb, P_BCNT, P_IDX, P_RANK, P_POS, P_ROWTOK, P_OFF, P_TILE, P_NT, tb == 0);
            SEAM(pb + 5);
        }
        if (IN(pb + 6)) {
            RELAUNDER();
            const int nu = group_setup(F, F.vcu, 2, P_TILE, P_NT, P_ROWTOK, true);
            pg8::SchedGroup<true> S{(const char*)P_XB, (const char*)(wsl + WS_W + (size_t)l * LW_STRIDE + LW_EGU), (const LAS int*)(F.lds + EXTRA_OFF), (const LAS int*)(F.lds + EXTRA_OFF + 256), nu, DM, 2};
            pg8::EpiGateUp E{P_HID};
            pg8::gemm_phase<pg8::EpiGateUp, pg8::SchedGroup<true>, true>(F.lds + RING_OFF, DM, S, E);
            SEAM(pb + 6);
        }
        if (IN(pb + 7)) {
            RELAUNDER();
            const int nu = group_setup(F, F.vcu, 4, P_TILE, P_NT, P_ROWTOK, false);
            pg8::SchedGroup<false> S{(const char*)P_HID, (const char*)(wsl + WS_W + (size_t)l * LW_STRIDE + LW_EDN), (const LAS int*)(F.lds + EXTRA_OFF), (const LAS int*)(F.lds + EXTRA_OFF + 256), nu, EDIM, 4};
            pg8::EpiStore E{P_YE, DM, 0};
            pg8::gemm_phase<pg8::EpiStore, pg8::SchedGroup<false>, true>(F.lds + RING_OFF, EDIM, S, E);
            SEAM(pb + 7);
        }
        if (IN(pb + 8)) {
            RELAUNDER();
            const int sbase = P_OFF[NEXP];
            for (int m = gw; m < NTOK / 2; m += NGW) { const int rows[2] = {m, m + NTOK / 2};
                combine_rows<2>(rows, F.lane, (l == DEPTH - 1) ? xf : (float*)nullptr, P_XB, P_YE, P_POS, P_WTS, sbase, args.in[22] + l * DM, args.in[23] + l * DM, alpha); }
            SEAM(pb + 8);
        }
    }
#undef IN
#undef SEAM
}
extern "C" void kernel_launch(void* const* d_in, const int* in_sizes, int n_in, void* d_out, int out_size, void* d_ws, size_t ws_size, hipStream_t stream) {
    static int grid = 0;
    if (grid == 0) {
        if (n_in != 24 || in_sizes[0] != NTOK * DM || out_size != NTOK * DM || ws_size < WS_MK_END) { fprintf(stderr, "kernel_launch: unexpected sizes n_in %d out %d ws %zu (need %zu); nothing launched\n", n_in, out_size, ws_size, (size_t)WS_MK_END); grid = -1; return; }
        int dev = 0, cus = 0, per_cu = 0;
        if (hipGetDevice(&dev) != hipSuccess || hipDeviceGetAttribute(&cus, hipDeviceAttributeMultiprocessorCount, dev) != hipSuccess) { fprintf(stderr, "kernel_launch: device query failed; nothing launched\n"); grid = -1; return; }
        if (hipFuncSetAttribute((const void*)mk_fwd, hipFuncAttributeMaxDynamicSharedMemorySize, LDS_BYTES) != hipSuccess) { fprintf(stderr, "kernel_launch: hipFuncSetAttribute failed; nothing launched\n"); grid = -1; return; }
        if (hipOccupancyMaxActiveBlocksPerMultiprocessor(&per_cu, (const void*)mk_fwd, NWAVES * 64, LDS_BYTES) != hipSuccess || per_cu < 1) fprintf(stderr, "kernel_launch: note: occupancy query reports %d workgroups per CU\n", per_cu);
        (void)hipGetLastError();
        grid = cus;
        if (grid != 256) fprintf(stderr, "kernel_launch: note: %d CUs (tuned for 256)\n", grid);
    }
    if (grid < 0) return;
    (void)hipMemsetAsync((char*)d_ws + WS_CTL, 0, 1 * MiB, stream);
    MkArgs a{};
    for (int i = 0; i < 24; ++i) a.in[i] = (const float*)d_in[i];
    a.out = (float*)d_out; a.ws = (unsigned char*)d_ws; a.ph_lo = 0; a.ph_hi = N_PHASES; a.li = 0; a.pad = 0;
    hipLaunchKernelGGL(mk_fwd, dim3(grid), dim3(NWAVES * 64), LDS_BYTES, stream, a);
}
```

```cpp
#include <hip/hip_runtime.h>
#include <stdint.h>
#include <stdio.h>
#include <math.h>

constexpr int NB = 4, SEQ = 4096, NTOK = NB * SEQ, DM = 1024, DEPTH = 4;
constexpr int DIN = 6656;
constexpr int C_UB = 1536;
constexpr int NEXP = 64, TOPK = 8, EDIM = 256;
constexpr int RELN = 513;
constexpr int MAXROWS = NTOK * TOPK + NTOK + NTOK;
constexpr float LN_EPS = 1e-5f;
constexpr float ROUTED_SCALE = 2.5f;

constexpr size_t MiB = 1u << 20;
constexpr size_t WS_CTL = 0;
constexpr size_t WS_SMALL = 1 * MiB;
constexpr size_t WS_XB = 32 * MiB;
constexpr size_t WS_Z = 96 * MiB;
constexpr size_t WS_YA = 512 * MiB, WS_YB = 544 * MiB, WS_YC = 576 * MiB;
constexpr size_t WS_MF = 608 * MiB;
constexpr size_t WS_MERGED = 672 * MiB;
constexpr size_t WS_HID = 736 * MiB;
constexpr size_t WS_YE = 896 * MiB;
constexpr size_t SM_IDX = 0, SM_WTS = 1 * MiB, SM_RANK = 2 * MiB, SM_POS = 3 * MiB, SM_ROWTOK = 4 * MiB, SM_OFF = 6 * MiB, SM_TILE = 6 * MiB + 4096, SM_NT = 6 * MiB + 16384, SM_LAM = 6 * MiB + 20480;
namespace pg8 {
#define PG8_LAS __attribute__((address_space(3)))
typedef short bf16x8 __attribute__((ext_vector_type(8)));
typedef float f32x4 __attribute__((ext_vector_type(4)));
typedef float f32x2 __attribute__((ext_vector_type(2)));
typedef unsigned u32x4 __attribute__((ext_vector_type(4)));
constexpr int BM = 256, BK = 64, HALF = 128, HTB = HALF * BK * 2  , STAGE_BYTES = 8 * HTB, NXCD = 8, WGM = 8;

__host__ __device__ __forceinline__ int lds_byte(int r, int c) { const int st = (r >> 4) * 2 + (c >> 5), rr = r & 15, cc = c & 31, ob = rr * 64 + cc * 2; return st * 1024 + (ob ^ (((ob >> 9) & 1) << 5)); }
__host__ __device__ __forceinline__ void stage_rc(int b, int& R, int& C) { const int st = b / 1024, sb = b % 1024, swz = sb ^ (((sb >> 9) & 1) << 5); R = (st >> 1) * 16 + swz / 64; C = (st & 1) * 32 + (swz % 64) / 2; }
__host__ __device__ __forceinline__ int perm16row(int R) { return (R >> 5) * 64 + ((R >> 2) & 3) * 16 + ((R >> 4) & 1) * 4 + (R & 3); }
__host__ __device__ __forceinline__ int perm32(int rho) { const int n = rho >> 4, i = rho & 15; return 8 * (i >> 2) + 4 * n + (i & 3); }

struct Unit { int pm, pn, e; };

__device__ __forceinline__ bool static_tile(int L, int nM, int nN, int& pm, int& pn) {
    const int nwg = nM * nN; if (L >= nwg) return false;
    int wgid = L; { const int q = nwg / NXCD, r = nwg % NXCD, xcd = wgid % NXCD, off = wgid / NXCD; wgid = (xcd < r ? xcd * (q + 1) : r * (q + 1) + (xcd - r) * q) + off; }
    const int nig = WGM * nN, gid = wgid / nig, fm = gid * WGM, gsz = (nM - fm) < WGM ? (nM - fm) : WGM;
    pm = fm + ((wgid % nig) % gsz); pn = (wgid % nig) / gsz; return true;
}
struct SchedDense {
    static constexpr bool GATHER = false;
    const char* A; const char* Bt; int nM, nN, G, c, K, pn0;
    __device__ __forceinline__ bool next(int i, Unit& u) const { u.e = 0; const bool ok = static_tile(i * G + c, nM, nN, u.pm, u.pn); u.pn += pn0; return ok; }
    __device__ __forceinline__ const char* a_ptr(const Unit& u) const { return A + (size_t)u.pm * (size_t)(BM * K * 2); }
    __device__ __forceinline__ const char* b_ptr(const Unit& u) const { return Bt + (size_t)u.pn * (size_t)(BM * K * 2); }
    __device__ __forceinline__ void offsA(int, const Unit&, const int (&)[2], const int (&)[2], unsigned (&)[2][2]) const {}
};
template <bool GATHER_> struct SchedGroup {
    static constexpr bool GATHER = GATHER_;
    const char* A; const char* Bt; const PG8_LAS int* ul; const PG8_LAS int* rt; int nu, K, NT;
    __device__ __forceinline__ bool next(int i, Unit& u) const { if (i >= nu) return false;
        u.pm = __builtin_amdgcn_readfirstlane(ul[4 * i]); u.pn = __builtin_amdgcn_readfirstlane(ul[4 * i + 1]); u.e = __builtin_amdgcn_readfirstlane(ul[4 * i + 2]); return true; }
    __device__ __forceinline__ const char* a_ptr(const Unit& u) const { return GATHER ? A : A + (size_t)u.pm * (size_t)(BM * K * 2); }
    __device__ __forceinline__ const char* b_ptr(const Unit& u) const { return Bt + (size_t)(u.e * NT + u.pn) * (size_t)(BM * K * 2); }
    __device__ __forceinline__ void offsA(int i, const Unit&, const int (&R)[2], const int (&C)[2], unsigned (&vo)[2][2]) const {
#pragma unroll
        for (int h = 0; h < 2; ++h)
#pragma unroll
            for (int j = 0; j < 2; ++j) vo[h][j] = (unsigned)(rt[256 * i + h * HALF + R[j]] * K + C[j]) * 2u;
    }
};

__device__ __forceinline__ unsigned cvt_pk_bf16(float lo, float hi) { unsigned r; asm("v_cvt_pk_bf16_f32 %0, %1, %2" : "=v"(r) : "v"(lo), "v"(hi)); return r; }
__device__ __forceinline__ u32x4 pack8(const f32x4 a, const f32x4 b) { u32x4 w; w.x = cvt_pk_bf16(a[0], a[1]); w.y = cvt_pk_bf16(a[2], a[3]); w.z = cvt_pk_bf16(b[0], b[1]); w.w = cvt_pk_bf16(b[2], b[3]); return w; }
__device__ __forceinline__ void st16(void* p, const u32x4 v) { __builtin_nontemporal_store(v, (u32x4*)p); }
__device__ __forceinline__ void st16d(void* p, const u32x4 v) { *(u32x4*)p = v; }
__device__ __forceinline__ float bflo(unsigned w) { return __uint_as_float(w << 16); }
__device__ __forceinline__ float bfhi(unsigned w) { return __uint_as_float(w & 0xffff0000u); }
__device__ __forceinline__ float fast_sigmoid(float v) { return __builtin_amdgcn_rcpf(1.f + __builtin_amdgcn_exp2f(-1.4426950408889634f * v)); }


struct EpiInproj {
    static constexpr bool PERM = true;
    unsigned short* Z; const float* cs;
    __device__ __forceinline__ void operator()(const f32x4 (&acc)[2][2][4][2], const Unit& u, int wr, int wc, int fr, int fq) const {
        const int pn = u.pn;
        const int mode = pn < 2 ? 1 : (pn == 8 || pn == 9) ? 2 : (pn == 10 || pn == 11) ? 3 : 0;
        const float sc = (mode == 1 || mode == 2) ? 0.18033688011112042f : 1.f;
        const int row0 = u.pm * BM + wr * 64 + fr, col0 = pn * BM + wc * 32 + 8 * fq;
        if ((mode == 2 || mode == 3) && ((wc & 1) == 0)) {
            const float sgn = (fq == 0) ? -1.f : 1.f;
#pragma unroll
            for (int ai = 0; ai < 2; ++ai)
#pragma unroll
                for (int m = 0; m < 4; ++m) {
                    const int row = row0 + ai * HALF + m * 16;
                    const float* cp = cs + (size_t)(row & 4095) * 16; const f32x4 cc0 = *(const f32x4*)cp, cc1 = *(const f32x4*)(cp + 4), ss0 = *(const f32x4*)(cp + 8), ss1 = *(const f32x4*)(cp + 12);
                    unsigned short* rowp = Z + (size_t)row * 6656 + col0;
#pragma unroll
                    for (int bj = 0; bj < 2; ++bj) {
                        f32x4 v0 = acc[ai][bj][m][0], v1 = acc[ai][bj][m][1], p0, p1;
#pragma unroll
                        for (int j = 0; j < 4; ++j) { p0[j] = __shfl_xor(v0[j], 16); p1[j] = __shfl_xor(v1[j], 16); }
                        if (fq < 2) { v0 = v0 * cc0 + (p0 * ss0) * sgn; v1 = v1 * cc1 + (p1 * ss1) * sgn; }
                        v0 = v0 * sc; v1 = v1 * sc;
                        st16d(rowp + bj * HALF, pack8(v0, v1));
                    }
                }
        } else {
#pragma unroll
            for (int ai = 0; ai < 2; ++ai)
#pragma unroll
                for (int m = 0; m < 4; ++m) { unsigned short* rowp = Z + (size_t)(row0 + ai * HALF + m * 16) * 6656 + col0;
#pragma unroll
                    for (int bj = 0; bj < 2; ++bj) st16d(rowp + bj * HALF, pack8(acc[ai][bj][m][0] * sc, acc[ai][bj][m][1] * sc)); }
        }
    }
};
struct EpiWout {
    static constexpr bool PERM = true;
    unsigned short* xb; float alpha; int pad;
    __device__ __forceinline__ void operator()(const f32x4 (&acc)[2][2][4][2], const Unit& u, int wr, int wc, int fr, int fq) const {
        const int row0 = u.pm * BM + wr * 64 + fr, col0 = u.pn * BM + wc * 32 + 8 * fq;
#pragma unroll
        for (int ai = 0; ai < 2; ++ai)
#pragma unroll
            for (int mh = 0; mh < 2; ++mh) {
                u32x4 pre[2][2];
#pragma unroll
                for (int mm = 0; mm < 2; ++mm)
#pragma unroll
                    for (int bj = 0; bj < 2; ++bj) pre[mm][bj] = *(const u32x4*)(xb + (size_t)(row0 + ai * HALF + (2 * mh + mm) * 16) * 1024 + col0 + bj * HALF);
#pragma unroll
                for (int mm = 0; mm < 2; ++mm)
#pragma unroll
                    for (int bj = 0; bj < 2; ++bj) { const int m = 2 * mh + mm; const u32x4 p = pre[mm][bj]; f32x4 v0 = acc[ai][bj][m][0], v1 = acc[ai][bj][m][1];
                        v0[0] += alpha * bflo(p.x); v0[1] += alpha * bfhi(p.x); v0[2] += alpha * bflo(p.y); v0[3] += alpha * bfhi(p.y); v1[0] += alpha * bflo(p.z); v1[1] += alpha * bfhi(p.z); v1[2] += alpha * bflo(p.w); v1[3] += alpha * bfhi(p.w);
                        st16d(xb + (size_t)(row0 + ai * HALF + m * 16) * 1024 + col0 + bj * HALF, pack8(v0, v1)); }
                asm volatile("" ::: "memory");
            }
    }
};
struct EpiGateUp {
    static constexpr bool PERM = true;
    unsigned short* HID;
    __device__ __forceinline__ void operator()(const f32x4 (&acc)[2][2][4][2], const Unit& u, int wr, int wc, int fr, int fq) const {
        const int row0 = u.pm * BM + wr * 64 + fr, col0 = u.pn * HALF + wc * 32 + 8 * fq;
#pragma unroll
        for (int ai = 0; ai < 2; ++ai)
#pragma unroll
            for (int m = 0; m < 4; ++m) {
                f32x4 h0, h1;
#pragma unroll
                for (int j = 0; j < 4; ++j) { const float g0 = acc[ai][0][m][0][j], g1 = acc[ai][0][m][1][j]; h0[j] = g0 * fast_sigmoid(g0) * acc[ai][1][m][0][j]; h1[j] = g1 * fast_sigmoid(g1) * acc[ai][1][m][1][j]; }
                st16(HID + (size_t)(row0 + ai * HALF + m * 16) * 256 + col0, pack8(h0, h1));
            }
    }
};
struct EpiStore {
    static constexpr bool PERM = true;
    unsigned short* O; int ldc; int pad;
    __device__ __forceinline__ void operator()(const f32x4 (&acc)[2][2][4][2], const Unit& u, int wr, int wc, int fr, int fq) const {
        const int row0 = u.pm * BM + wr * 64 + fr, col0 = u.pn * BM + wc * 32 + 8 * fq;
#pragma unroll
        for (int ai = 0; ai < 2; ++ai)
#pragma unroll
            for (int m = 0; m < 4; ++m) { unsigned short* rowp = O + (size_t)(row0 + ai * HALF + m * 16) * ldc + col0;
#pragma unroll
                for (int bj = 0; bj < 2; ++bj) st16(rowp + bj * HALF, pack8(acc[ai][bj][m][0], acc[ai][bj][m][1])); }
    }
};

__device__ __forceinline__ unsigned pk4_fp8(const f32x4 v, float sc) {
    const float a = __builtin_amdgcn_fmed3f(v[0] * sc, -440.f, 440.f), b = __builtin_amdgcn_fmed3f(v[1] * sc, -440.f, 440.f), c = __builtin_amdgcn_fmed3f(v[2] * sc, -440.f, 440.f), d = __builtin_amdgcn_fmed3f(v[3] * sc, -440.f, 440.f);
    int w = __builtin_amdgcn_cvt_pk_fp8_f32(a, b, 0, false); w = __builtin_amdgcn_cvt_pk_fp8_f32(c, d, w, true); return (unsigned)w; }
struct EpiStore8 {
    static constexpr int PERM = 2;
    unsigned char* O; float scale; int pad;
    __device__ __forceinline__ void operator()(const f32x4 (&acc)[2][2][4][2], const Unit& u, int wr, int wc, int fr, int fq) const {
        const int row0 = u.pm * BM + wr * 64 + fr, col0 = u.pn * BM + wc * 64 + fq * 16;
#pragma unroll
        for (int ai = 0; ai < 2; ++ai)
#pragma unroll
            for (int m = 0; m < 4; ++m) { u32x4 w; w.x = pk4_fp8(acc[ai][0][m][0], scale); w.y = pk4_fp8(acc[ai][0][m][1], scale); w.z = pk4_fp8(acc[ai][1][m][0], scale); w.w = pk4_fp8(acc[ai][1][m][1], scale);
                *(u32x4*)(O + (size_t)(row0 + ai * HALF + m * 16) * 1024 + col0) = w; }
    }
};

constexpr float GATE_SCALE = 256.f;
struct EpiGate8 {
    static constexpr int PERM = 2;
    unsigned char* G; int pad0, pad1;
    __device__ __forceinline__ void operator()(const f32x4 (&acc)[2][2][4][2], const Unit& u, int wr, int wc, int fr, int fq) const {
        const int row0 = u.pm * BM + wr * 64 + fr, col0 = (u.pn - 14) * BM + wc * 64 + fq * 16;
#pragma unroll
        for (int ai = 0; ai < 2; ++ai)
#pragma unroll
            for (int m = 0; m < 4; ++m) { u32x4 w; f32x4 t;
#define PG8_SIG4(dst, src) do { _Pragma("unroll") for (int j = 0; j < 4; ++j) t[j] = fast_sigmoid(src[j]); dst = pk4_fp8(t, GATE_SCALE); } while (0)
                PG8_SIG4(w.x, acc[ai][0][m][0]); PG8_SIG4(w.y, acc[ai][0][m][1]); PG8_SIG4(w.z, acc[ai][1][m][0]); PG8_SIG4(w.w, acc[ai][1][m][1]);
#undef PG8_SIG4
                st16d(G + (size_t)(row0 + ai * HALF + m * 16) * 3072 + col0, w); }
    }
};

template <class Epi, class Sched, bool ALIGN_EPI>
__device__ __forceinline__ void gemm_phase(PG8_LAS unsigned char* lds, const int K, const Sched& S, const Epi& E) {
    int tid_ = threadIdx.x; asm volatile("" : "+v"(tid_));
    const int tid = tid_, wid = __builtin_amdgcn_readfirstlane(tid >> 6), lane = tid & 63, wr = wid >> 2, wc = wid & 3, fr = lane & 15, fq = lane >> 4;
    const int nt = K / BK;
    int Rr[2], Cc[2];
    unsigned voffA[2][2], voffB[2];
#pragma unroll
    for (int i = 0; i < 2; ++i) { stage_rc(tid * 16 + i * 8192, Rr[i], Cc[i]); const int Rb = ((int)Epi::PERM == 2) ? perm16row(Rr[i]) : Epi::PERM ? ((Rr[i] & ~31) + perm32(Rr[i] & 31)) : Rr[i];
        voffA[0][i] = (unsigned)(Rr[i] * K + Cc[i]) * 2u; voffA[1][i] = (unsigned)((Rr[i] + HALF) * K + Cc[i]) * 2u; voffB[i] = (unsigned)(Rb * K + Cc[i]) * 2u; }
    const size_t kstep = (size_t)(BK * 2);
    const size_t hstep = ((int)Epi::PERM == 2) ? (size_t)8 * K * 2 : (size_t)HALF * K * 2;
    const unsigned ldsw = (unsigned)wid * 1024u;
    const int aoff = lds_byte(wr * 64 + fr, fq * 8), boff = lds_byte(wc * 32 + fr, fq * 8);
#define PG8_SA(b, h) (((b) * 2 + (h)) * HTB)
#define PG8_SB(b, h) ((4 + (b) * 2 + (h)) * HTB)
#define PG8_STAGE(bufoff, gbase, voff) do { _Pragma("unroll") for (int _i = 0; _i < 2; ++_i) \
        __builtin_amdgcn_global_load_lds((const unsigned*)((const char*)(gbase) + (voff)[_i]), (PG8_LAS unsigned*)(lds + (bufoff) + ldsw + _i * 8192), 16, 0, 0); } while (0)
#define PG8_LDA(dst, b, h) do { _Pragma("unroll") for (int m = 0; m < 4; ++m) _Pragma("unroll") for (int k = 0; k < 2; ++k) dst[m][k] = *(const PG8_LAS bf16x8*)(lds + PG8_SA(b, h) + aoff + m * 2048 + k * 1024); } while (0)
#define PG8_LDB(dst, b, h) do { _Pragma("unroll") for (int n = 0; n < 2; ++n) _Pragma("unroll") for (int k = 0; k < 2; ++k) dst[n][k] = *(const PG8_LAS bf16x8*)(lds + PG8_SB(b, h) + boff + n * 2048 + k * 1024); } while (0)
#define PG8_MMA(ai, bj, At, Bt) do { __builtin_amdgcn_s_setprio(1); _Pragma("unroll") for (int m = 0; m < 4; ++m) _Pragma("unroll") for (int n = 0; n < 2; ++n) _Pragma("unroll") for (int k = 0; k < 2; ++k) \
        acc[ai][bj][m][n] = __builtin_amdgcn_mfma_f32_16x16x32_bf16(Bt[n][k], At[m][k], acc[ai][bj][m][n], 0, 0, 0); __builtin_amdgcn_s_setprio(0); } while (0)
#define PG8_WAIT_V(n) asm volatile("s_waitcnt vmcnt(" #n ")" ::: "memory")
#define PG8_WAIT_L(n) asm volatile("s_waitcnt lgkmcnt(" #n ")" ::: "memory")
#define PG8_BAR __builtin_amdgcn_s_barrier()
#define PG8_SCHED __builtin_amdgcn_sched_barrier(0)
    Unit cur, nxt; int ui = 0;
    if (!S.next(0, cur)) return;
    if constexpr (Sched::GATHER) S.offsA(0, cur, Rr, Cc, voffA);
    f32x4 acc[2][2][4][2];
#pragma unroll
    for (int a = 0; a < 2; ++a)
#pragma unroll
        for (int b = 0; b < 2; ++b)
#pragma unroll
            for (int m = 0; m < 4; ++m)
#pragma unroll
                for (int n = 0; n < 2; ++n) acc[a][b][m][n] = (f32x4){0.f, 0.f, 0.f, 0.f};
    bf16x8 At[4][2], B0[2][2], B1[2][2];
    const char* cA = S.a_ptr(cur); const char* cB = S.b_ptr(cur);
    PG8_STAGE(PG8_SB(0, 0), cB, voffB); PG8_STAGE(PG8_SB(0, 1), cB + hstep, voffB); PG8_STAGE(PG8_SA(0, 0), cA, voffA[0]); PG8_STAGE(PG8_SA(0, 1), cA, voffA[1]);
    if (wr == 1) PG8_BAR;
    PG8_WAIT_V(2); PG8_BAR;
    PG8_STAGE(PG8_SB(1, 0), cB + kstep, voffB); PG8_STAGE(PG8_SA(1, 0), cA + kstep, voffA[0]); PG8_STAGE(PG8_SB(1, 1), cB + hstep + kstep, voffB);
    PG8_WAIT_V(6); PG8_BAR;
    for (;;) {
        const bool has_next = S.next(ui + 1, nxt);
        const char* nA = has_next ? S.a_ptr(nxt) : cA; const char* nB = has_next ? S.b_ptr(nxt) : cB;
#pragma clang loop unroll(disable)
        for (int t = 0; t < nt; t += 2) {
            const bool last = (t == nt - 2);
            const char* a1 = cA + (size_t)(t + 1) * kstep;
            const char* a2 = last ? nA : cA + (size_t)(t + 2) * kstep; const char* b2 = last ? nB : cB + (size_t)(t + 2) * kstep;
            const char* a3 = a2 + kstep; const char* b3 = b2 + kstep;
            PG8_LDB(B0, 0, 0); PG8_LDB(B1, 0, 1); PG8_SCHED; PG8_LDA(At, 0, 0); PG8_STAGE(PG8_SA(1, 1), a1, voffA[1]);
            if constexpr (Sched::GATHER) { if (last && has_next) S.offsA(ui + 1, nxt, Rr, Cc, voffA); }
            PG8_WAIT_V(8); PG8_WAIT_L(0); PG8_BAR; PG8_MMA(0, 0, At, B0); PG8_MMA(0, 1, At, B1); PG8_BAR; PG8_SCHED;
            PG8_LDA(At, 0, 1); PG8_STAGE(PG8_SB(0, 0), b2, voffB); PG8_STAGE(PG8_SB(0, 1), b2 + hstep, voffB); PG8_STAGE(PG8_SA(0, 0), a2, voffA[0]);
            PG8_WAIT_V(8); PG8_WAIT_L(0); PG8_BAR; PG8_MMA(1, 0, At, B0); PG8_MMA(1, 1, At, B1); PG8_BAR; PG8_SCHED;
            PG8_LDB(B0, 1, 0); PG8_LDB(B1, 1, 1); PG8_SCHED; PG8_LDA(At, 1, 0); PG8_STAGE(PG8_SA(0, 1), a2, voffA[1]);
            PG8_WAIT_V(8); PG8_WAIT_L(0); PG8_BAR; PG8_MMA(0, 0, At, B0); PG8_MMA(0, 1, At, B1); PG8_BAR; PG8_SCHED;
            PG8_LDA(At, 1, 1); PG8_STAGE(PG8_SB(1, 0), b3, voffB); PG8_STAGE(PG8_SB(1, 1), b3 + hstep, voffB); PG8_STAGE(PG8_SA(1, 0), a3, voffA[0]);
            PG8_WAIT_V(8); PG8_WAIT_L(0); PG8_BAR; PG8_MMA(1, 0, At, B0); PG8_MMA(1, 1, At, B1); PG8_BAR; PG8_SCHED;
        }
        if constexpr (ALIGN_EPI) { if (wr == 0) PG8_BAR; }
        E(acc, cur, wr, wc, fr, fq);
        if (!has_next) break;
#pragma unroll
        for (int a = 0; a < 2; ++a)
#pragma unroll
            for (int b = 0; b < 2; ++b)
#pragma unroll
                for (int m = 0; m < 4; ++m)
#pragma unroll
                    for (int n = 0; n < 2; ++n) acc[a][b][m][n] = (f32x4){0.f, 0.f, 0.f, 0.f};
        cur = nxt; cA = nA; cB = nB; ++ui;
        if constexpr (ALIGN_EPI) { if (wr == 1) PG8_BAR; }
    }
    PG8_WAIT_V(0);
    if constexpr (!ALIGN_EPI) { if (wr == 0) PG8_BAR; }
    PG8_BAR;
#undef PG8_SA
#undef PG8_SB
#undef PG8_STAGE
#undef PG8_LDA
#undef PG8_LDB
#undef PG8_MMA
#undef PG8_WAIT_V
#undef PG8_WAIT_L
#undef PG8_BAR
#undef PG8_SCHED
}
struct SchedBranchHN {
    static constexpr bool GATHER = false;
    const char* A; const char* Bt; size_t astride, bstride; int G, c, K;
    __device__ __forceinline__ bool next(int i, Unit& u) const { u.e = i % 3; const int L = (i / 3) * G + c; if (L >= 512) return false; u.pm = L >> 3; u.pn = L & 7; return true; }
    __device__ __forceinline__ const char* a_ptr(const Unit& u) const { return A + (size_t)u.e * astride + (size_t)u.pm * (size_t)(BM * K * 2); }
    __device__ __forceinline__ const char* b_ptr(const Unit& u) const { return Bt + (size_t)u.e * bstride + (size_t)u.pn * (size_t)(HALF * K * 2); }
};
struct EpiBranchHN {
    unsigned short* merged; const unsigned char* G;
    __device__ __forceinline__ void operator()(const f32x4 (&acc)[2][4][2], f32x4 (&tot)[2][4][2], const Unit& u, int wr, int wc, int fr, int fq) const {
        const int br = u.e; const int row0 = u.pm * BM + wr * 64 + fr, col0 = u.pn * HALF + wc * 32 + 8 * fq;
        const unsigned char* gbase = G + br * 1024 + col0;
#pragma unroll
        for (int ai = 0; ai < 2; ++ai) {
            unsigned gx[4], gy[4];
#pragma unroll
            for (int m = 0; m < 4; ++m) { const unsigned* gp = (const unsigned*)(gbase + (size_t)(row0 + ai * HALF + m * 16) * 3072); gx[m] = gp[0]; gy[m] = gp[1]; }
#pragma unroll
            for (int m = 0; m < 4; ++m) { f32x4 v0 = acc[ai][m][0] * (1.f / GATE_SCALE), v1 = acc[ai][m][1] * (1.f / GATE_SCALE);
                const f32x2 g01 = __builtin_amdgcn_cvt_pk_f32_fp8((int)gx[m], false), g23 = __builtin_amdgcn_cvt_pk_f32_fp8((int)gx[m], true), g45 = __builtin_amdgcn_cvt_pk_f32_fp8((int)gy[m], false), g67 = __builtin_amdgcn_cvt_pk_f32_fp8((int)gy[m], true);
                v0[0] *= g01[0]; v0[1] *= g01[1]; v0[2] *= g23[0]; v0[3] *= g23[1]; v1[0] *= g45[0]; v1[1] *= g45[1]; v1[2] *= g67[0]; v1[3] *= g67[1];
                if (br == 0) { tot[ai][m][0] = v0; tot[ai][m][1] = v1; } else { tot[ai][m][0] += v0; tot[ai][m][1] += v1; }
                if (br == 2) st16d(merged + (size_t)(row0 + ai * HALF + m * 16) * 1024 + col0, pack8(tot[ai][m][0], tot[ai][m][1])); }
            asm volatile("" ::: "memory");
        }
    }
};
struct SchedInprojHN {
    static constexpr bool GATHER = false;
    const char* A; const char* Bt; int G, c, K;
    __device__ __forceinline__ bool next(int i, Unit& u) const { u.e = 0; const int L = i * G + c; if (L >= 256) return false; u.pm = L >> 2; u.pn = 24 + (L & 3); return true; }
    __device__ __forceinline__ const char* a_ptr(const Unit& u) const { return A + (size_t)u.pm * (size_t)(BM * K * 2); }
    __device__ __forceinline__ const char* b_ptr(const Unit& u) const { return Bt + (size_t)u.pn * (size_t)(HALF * K * 2); }
};
struct EpiInprojHN {
    unsigned short* Z; int pad0, pad1;
    __device__ __forceinline__ void operator()(const f32x4 (&acc)[2][4][2], f32x4 (&)[2][4][2], const Unit& u, int wr, int wc, int fr, int fq) const {
        const int row0 = u.pm * BM + wr * 64 + fr, col0 = u.pn * HALF + wc * 32 + 8 * fq;
#pragma unroll
        for (int ai = 0; ai < 2; ++ai)
#pragma unroll
            for (int m = 0; m < 4; ++m) st16d(Z + (size_t)(row0 + ai * HALF + m * 16) * 6656 + col0, pack8(acc[ai][m][0], acc[ai][m][1]));
    }
};
template <class Epi, class Sched>
__device__ __forceinline__ void gemm_phase_hn(PG8_LAS unsigned char* lds, const int K, const Sched& S, const Epi& E) {
    int tid_ = threadIdx.x; asm volatile("" : "+v"(tid_));
    const int tid = tid_, wid = __builtin_amdgcn_readfirstlane(tid >> 6), lane = tid & 63, wr = wid >> 2, wc = wid & 3, fr = lane & 15, fq = lane >> 4;
    const int nt = K / BK;
    unsigned voffA[2][2], voffB[2];
#pragma unroll
    for (int i = 0; i < 2; ++i) { int R, C; stage_rc(tid * 16 + i * 8192, R, C); const int Rb = (R & ~31) + perm32(R & 31);
        voffA[0][i] = (unsigned)(R * K + C) * 2u; voffA[1][i] = (unsigned)((R + HALF) * K + C) * 2u; voffB[i] = (unsigned)(Rb * K + C) * 2u; }
    const size_t kstep = (size_t)(BK * 2);
    const unsigned ldsw = (unsigned)wid * 1024u;
    const int aoff = lds_byte(wr * 64 + fr, fq * 8), boff = lds_byte(wc * 32 + fr, fq * 8);
#define PG8_SA(b, h) (((b) * 2 + (h)) * HTB)
#define PG8_SB(b, h) ((4 + (b) * 2 + (h)) * HTB)
#define PG8_STAGE(bufoff, gbase, voff) do { _Pragma("unroll") for (int _i = 0; _i < 2; ++_i) \
        __builtin_amdgcn_global_load_lds((const unsigned*)((const char*)(gbase) + (voff)[_i]), (PG8_LAS unsigned*)(lds + (bufoff) + ldsw + _i * 8192), 16, 0, 0); } while (0)
#define PG8_LDA(dst, b, h) do { _Pragma("unroll") for (int m = 0; m < 4; ++m) _Pragma("unroll") for (int k = 0; k < 2; ++k) dst[m][k] = *(const PG8_LAS bf16x8*)(lds + PG8_SA(b, h) + aoff + m * 2048 + k * 1024); } while (0)
#define PG8_LDB(dst, b, h) do { _Pragma("unroll") for (int n = 0; n < 2; ++n) _Pragma("unroll") for (int k = 0; k < 2; ++k) dst[n][k] = *(const PG8_LAS bf16x8*)(lds + PG8_SB(b, h) + boff + n * 2048 + k * 1024); } while (0)
#define PG8_MMA(ai, At, Bt) do { __builtin_amdgcn_s_setprio(1); _Pragma("unroll") for (int m = 0; m < 4; ++m) _Pragma("unroll") for (int n = 0; n < 2; ++n) _Pragma("unroll") for (int k = 0; k < 2; ++k) \
        acc[ai][m][n] = __builtin_amdgcn_mfma_f32_16x16x32_bf16(Bt[n][k], At[m][k], acc[ai][m][n], 0, 0, 0); __builtin_amdgcn_s_setprio(0); } while (0)
#define PG8_WAIT_V(n) asm volatile("s_waitcnt vmcnt(" #n ")" ::: "memory")
#define PG8_WAIT_L(n) asm volatile("s_waitcnt lgkmcnt(" #n ")" ::: "memory")
#define PG8_BAR __builtin_amdgcn_s_barrier()
#define PG8_SCHED __builtin_amdgcn_sched_barrier(0)
    Unit cur, nxt; int ui = 0;
    if (!S.next(0, cur)) return;
    f32x4 acc[2][4][2], tot[2][4][2];
#pragma unroll
    for (int a = 0; a < 2; ++a)
#pragma unroll
        for (int m = 0; m < 4; ++m)
#pragma unroll
            for (int n = 0; n < 2; ++n) { acc[a][m][n] = (f32x4){0.f, 0.f, 0.f, 0.f}; tot[a][m][n] = (f32x4){0.f, 0.f, 0.f, 0.f}; }
    bf16x8 At[4][2], B0[2][2];
    const char* cA = S.a_ptr(cur); const char* cB = S.b_ptr(cur);
    PG8_STAGE(PG8_SB(0, 0), cB, voffB); PG8_STAGE(PG8_SA(0, 0), cA, voffA[0]); PG8_STAGE(PG8_SA(0, 1), cA, voffA[1]);
    if (wr == 1) PG8_BAR;
    PG8_WAIT_V(2); PG8_BAR;
    PG8_STAGE(PG8_SB(1, 0), cB + kstep, voffB); PG8_STAGE(PG8_SA(1, 0), cA + kstep, voffA[0]);
    PG8_WAIT_V(4); PG8_BAR;
    for (;;) {
        const bool has_next = S.next(ui + 1, nxt);
        const char* nA = has_next ? S.a_ptr(nxt) : cA; const char* nB = has_next ? S.b_ptr(nxt) : cB;
#pragma clang loop unroll(disable)
        for (int t = 0; t < nt; t += 2) {
            const bool last = (t == nt - 2);
            const char* a1 = cA + (size_t)(t + 1) * kstep;
            const char* a2 = last ? nA : cA + (size_t)(t + 2) * kstep; const char* b2 = last ? nB : cB + (size_t)(t + 2) * kstep;
            const char* a3 = a2 + kstep; const char* b3 = b2 + kstep;
            PG8_LDB(B0, 0, 0); PG8_SCHED; PG8_LDA(At, 0, 0); PG8_STAGE(PG8_SA(1, 1), a1, voffA[1]);
            PG8_WAIT_V(6); PG8_WAIT_L(0); PG8_BAR; PG8_MMA(0, At, B0); PG8_BAR; PG8_SCHED;
            PG8_LDA(At, 0, 1); PG8_STAGE(PG8_SB(0, 0), b2, voffB); PG8_STAGE(PG8_SA(0, 0), a2, voffA[0]);
            PG8_WAIT_V(6); PG8_WAIT_L(0); PG8_BAR; PG8_MMA(1, At, B0); PG8_BAR; PG8_SCHED;
            PG8_LDB(B0, 1, 0); PG8_SCHED; PG8_LDA(At, 1, 0); PG8_STAGE(PG8_SA(0, 1), a2, voffA[1]);
            PG8_WAIT_V(6); PG8_WAIT_L(0); PG8_BAR; PG8_MMA(0, At, B0); PG8_BAR; PG8_SCHED;
            PG8_LDA(At, 1, 1); PG8_STAGE(PG8_SB(1, 0), b3, voffB); PG8_STAGE(PG8_SA(1, 0), a3, voffA[0]);
            PG8_WAIT_V(6); PG8_WAIT_L(0); PG8_BAR; PG8_MMA(1, At, B0); PG8_BAR; PG8_SCHED;
        }
        if (wr == 0) PG8_BAR;
        E(acc, tot, cur, wr, wc, fr, fq);
        if (!has_next) break;
#pragma unroll
        for (int a = 0; a < 2; ++a)
#pragma unroll
            for (int m = 0; m < 4; ++m)
#pragma unroll
                for (int n = 0; n < 2; ++n) acc[a][m][n] = (f32x4){0.f, 0.f, 0.f, 0.f};
        cur = nxt; cA = nA; cB = nB; ++ui;
        if (wr == 1) PG8_BAR;
    }
    PG8_WAIT_V(0);
    PG8_BAR;
#undef PG8_SA
#undef PG8_SB
#undef PG8_STAGE
#undef PG8_LDA
#undef PG8_LDB
#undef PG8_MMA
#undef PG8_WAIT_V
#undef PG8_WAIT_L
#undef PG8_BAR
#undef PG8_SCHED
}
}
namespace att {
#define ATT_LAS __attribute__((address_space(3)))
typedef short bf16x8 __attribute__((ext_vector_type(8)));
typedef short s16x4 __attribute__((ext_vector_type(4)));
typedef float f32x16 __attribute__((ext_vector_type(16)));
typedef unsigned u32x4 __attribute__((ext_vector_type(4)));
constexpr int ZP = 6656;
constexpr int BUFB = 32768;
constexpr int NBUF = 3;
constexpr int L_WSF = NBUF * BUFB, L_BIAS = L_WSF + 8 * 256, L_END = L_BIAS + 2 * 520 * 4;
__device__ __forceinline__ int crow(int r, int hi) { return (r & 3) + 8 * (r >> 2) + 4 * hi; }
__device__ __forceinline__ unsigned cvtpk(float lo, float hi) { unsigned r; asm("v_cvt_pk_bf16_f32 %0, %1, %2" : "=v"(r) : "v"(lo), "v"(hi)); return r; }
__device__ __forceinline__ s16x4 vtr(const ATT_LAS unsigned char* p) { typedef short v4i16_t __attribute__((ext_vector_type(4)));
    return __builtin_bit_cast(s16x4, __builtin_amdgcn_ds_read_tr16_b64_v4i16((ATT_LAS v4i16_t*)p)); }

__device__ __forceinline__ void issue_tile(ATT_LAS unsigned char* lds, int boff, const unsigned short* Z, int krow0, int kcol, int vcol, int wid, int lane) {
#pragma unroll
    for (int j = 0; j < 2; ++j) {
        const int pc = 2 * wid + j, s = pc >> 3, c = pc & 7;
        const unsigned short* ks = Z + (size_t)(krow0 + 8 * c + (lane >> 3)) * ZP + kcol + s * 64 + (((lane & 7) ^ (((c >> 1) & 1) * 4 + (lane >> 4))) * 8);
        __builtin_amdgcn_global_load_lds((const unsigned*)ks, (ATT_LAS unsigned*)(lds + boff + s * 8192 + c * 1024), 16, 0, 0);
        const unsigned short* vs = Z + (size_t)(krow0 + 16 * (c & 3) + (lane >> 2)) * ZP + vcol + s * 64 + (c >> 2) * 32 + (lane & 3) * 8;
        __builtin_amdgcn_global_load_lds((const unsigned*)vs, (ATT_LAS unsigned*)(lds + boff + 16384 + s * 8192 + c * 1024), 16, 0, 0);
    }
}

template <int MODE>
__device__ __forceinline__ void attn_unit(ATT_LAS unsigned char* lds, const unsigned short* __restrict__ Z, int b, int hp, int qb, const float* __restrict__ bias, float lam, float oml, const float* __restrict__ subg, unsigned short* __restrict__ Y) {
    constexpr int NDB = MODE ? 4 : 2;
    int tid_ = threadIdx.x; asm volatile("" : "+v"(tid_));
    const int tid = tid_, lane = tid & 63, r32 = lane & 31, hi = lane >> 5, wid = __builtin_amdgcn_readfirstlane(tid >> 6), grp = wid >> 2, wq = wid & 3;
    const int rowbase = b * 4096, q0 = qb * 128 + wq * 32, qc = 2 * qb + (wq >> 1);
    const int qcol = MODE ? (2048 + hp * 128 + grp * 64) : (0 + (2 * hp + grp) * 64);
    const int kcol = MODE ? (2560 + hp * 128) : (512 + hp * 128), vcol = MODE ? (3072 + hp * 128) : (1024 + hp * 128);
    const int t_lo = MODE ? 0 : ((2 * qb - 8) > 0 ? (2 * qb - 8) : 0), t_hi = 2 * qb + 1;
    ATT_LAS float* wsf = (ATT_LAS float*)(lds + L_WSF) + wid * 64;
    ATT_LAS float* bl = (ATT_LAS float*)(lds + L_BIAS);
    issue_tile(lds, 0, Z, rowbase + t_lo * 64, kcol, vcol, wid, lane);
    issue_tile(lds, BUFB, Z, rowbase + (t_lo + 1) * 64, kcol, vcol, wid, lane);
    if (MODE == 0) { for (int i = tid; i < 2 * 513; i += 512) { const int g = i / 513, j = i % 513; bl[g * 520 + j] = bias[(2 * hp + g) * 513 + j] * 1.4426950408889634f; } }
    bf16x8 qr[4];
#pragma unroll
    for (int d0 = 0; d0 < 4; ++d0) qr[d0] = *(const bf16x8*)(Z + (size_t)(rowbase + q0 + r32) * ZP + qcol + d0 * 16 + hi * 8);
    f32x16 o[NDB];
#pragma unroll
    for (int d = 0; d < NDB; ++d) o[d] = f32x16{};
    float m_run = -INFINITY, l_run = 0.f;
    const int vlane = ((lane >> 4) & 1) * 32 + (lane & 3) * 8 + (4 * hi + ((lane & 15) >> 2)) * 64;
    const int koff = r32 * 128 + ((hi ^ (((r32 >> 1) & 3) + ((r32 >> 4) & 1) * 4)) << 4);
    int bi = 0;
    for (int t = t_lo; t <= t_hi; ++t) {
        const int boff = bi * BUFB;
        if (t < t_hi) asm volatile("s_waitcnt vmcnt(4) lgkmcnt(0)\n\ts_barrier" ::: "memory");
        else asm volatile("s_waitcnt vmcnt(0) lgkmcnt(0)\n\ts_barrier" ::: "memory");
        { const int b2 = (bi == 0) ? 2 : bi - 1;
          if (t + 2 <= t_hi) issue_tile(lds, b2 * BUFB, Z, rowbase + (t + 2) * 64, kcol, vcol, wid, lane); }
        bi = (bi == NBUF - 1) ? 0 : bi + 1;
        const bool active = MODE ? (t <= qc) : (t >= qc - 8 && t <= qc);
        if (active) {
            f32x16 p0 = f32x16{}, p1 = f32x16{};
            const ATT_LAS unsigned char* kb = lds + boff + grp * 8192;
#pragma unroll
            for (int d0 = 0; d0 < 4; ++d0) {
                const bf16x8 b0 = *(const ATT_LAS bf16x8*)(kb + (koff ^ (d0 << 5))), b1 = *(const ATT_LAS bf16x8*)(kb + (koff ^ (d0 << 5)) + 4096);
                p0 = __builtin_amdgcn_mfma_f32_32x32x16_bf16(b0, qr[d0], p0, 0, 0, 0);
                p1 = __builtin_amdgcn_mfma_f32_32x32x16_bf16(b1, qr[d0], p1, 0, 0, 0);
            }
            if (MODE == 0) {
                const int dc = qc - t;
                const ATT_LAS float* bg = bl + grp * 520;
                if (dc >= 5) { const float cb = bg[512];
#pragma unroll
                    for (int r = 0; r < 16; ++r) { p0[r] += cb; p1[r] += cb; } }
                else { const int base = dc * 64 + (wq & 1) * 32 + r32 + 256;
#pragma unroll
                    for (int r = 0; r < 16; ++r) { int i0 = base - crow(r, hi), i1 = i0 - 32; i0 = i0 > 512 ? 512 : i0; i1 = i1 > 512 ? 512 : i1; p0[r] += bg[i0]; p1[r] += bg[i1]; } }
            }
            float rm = p0[0];
#pragma unroll
            for (int r = 1; r < 16; ++r) rm = fmaxf(rm, p0[r]);
#pragma unroll
            for (int r = 0; r < 16; ++r) rm = fmaxf(rm, p1[r]);
            rm = fmaxf(rm, __shfl_xor(rm, 32));
            if (__any(rm > m_run + 8.0f)) {
                const float mn = fmaxf(m_run, rm); const float alpha = __builtin_amdgcn_exp2f(m_run - mn); m_run = mn; l_run *= alpha;
                if (hi == 0) wsf[r32] = alpha;
                asm volatile("s_waitcnt lgkmcnt(0)" ::: "memory");
#pragma unroll
                for (int r = 0; r < 16; ++r) { const float a = wsf[crow(r, hi)];
#pragma unroll
                    for (int d = 0; d < NDB; ++d) o[d][r] *= a; }
            }
            float ls = 0.f;
#pragma unroll
            for (int r = 0; r < 16; ++r) { p0[r] = __builtin_amdgcn_exp2f(p0[r] - m_run); p1[r] = __builtin_amdgcn_exp2f(p1[r] - m_run); ls += p0[r] + p1[r]; }
            l_run += ls;
            u32x4 pw[4];
#pragma unroll
            for (int j = 0; j < 4; ++j) { pw[0][j] = cvtpk(p0[2 * j], p0[2 * j + 1]); pw[1][j] = cvtpk(p0[8 + 2 * j], p0[9 + 2 * j]); pw[2][j] = cvtpk(p1[2 * j], p1[2 * j + 1]); pw[3][j] = cvtpk(p1[8 + 2 * j], p1[9 + 2 * j]); }
#pragma unroll
            for (int d = 0; d < NDB; ++d) {
                const int voff = 16384 + (MODE ? ((d >> 1) * 8192 + (d & 1) * 4096) : (grp * 8192 + d * 4096));
                const ATT_LAS unsigned char* vp = lds + boff + voff + vlane;
                s16x4 vl[4], vh[4];
#pragma unroll
                for (int ks = 0; ks < 4; ++ks) { vl[ks] = vtr(vp + ks * 1024); vh[ks] = vtr(vp + ks * 1024 + 512); }
#pragma unroll
                for (int ks = 0; ks < 4; ++ks) { const bf16x8 vf = (bf16x8){vl[ks][0], vl[ks][1], vl[ks][2], vl[ks][3], vh[ks][0], vh[ks][1], vh[ks][2], vh[ks][3]};
                    o[d] = __builtin_amdgcn_mfma_f32_32x32x16_bf16(__builtin_bit_cast(bf16x8, pw[ks]), vf, o[d], 0, 0, 0); }
            }
        }
    }
    __syncthreads();
    const float lfull = l_run + __shfl_xor(l_run, 32);
    const size_t yrow0 = (size_t)(rowbase + q0);
    if (MODE == 0) {
        if (hi == 0) wsf[r32] = __builtin_amdgcn_rcpf(lfull);
        asm volatile("s_waitcnt lgkmcnt(0)" ::: "memory");
        ATT_LAS unsigned short* stg = (ATT_LAS unsigned short*)(lds + wid * 4096);
#pragma unroll
        for (int r = 0; r < 16; ++r) { const float a = wsf[crow(r, hi)];
#pragma unroll
            for (int d = 0; d < NDB; ++d) stg[crow(r, hi) * 64 + d * 32 + r32] = (unsigned short)(cvtpk(o[d][r] * a, 0.f) & 0xffffu); }
        asm volatile("s_waitcnt lgkmcnt(0)" ::: "memory");
#pragma unroll
        for (int i = 0; i < 4; ++i) { const int row = i * 8 + (lane >> 3), ch = lane & 7; const u32x4 v = *(const ATT_LAS u32x4*)(stg + row * 64 + ch * 8);
            *(u32x4*)(Y + (yrow0 + row) * 512 + (2 * hp + grp) * 64 + ch * 8) = v; }
    } else {
        ATT_LAS float* xch = (ATT_LAS float*)lds;
        if (hi == 0) wsf[r32] = (grp ? lam : 1.f) * __builtin_amdgcn_rcpf(lfull);
        asm volatile("s_waitcnt lgkmcnt(0)" ::: "memory");
        float a[16];
#pragma unroll
        for (int r = 0; r < 16; ++r) a[r] = wsf[crow(r, hi)];
        if (grp == 1) {
#pragma unroll
            for (int r = 0; r < 16; ++r)
#pragma unroll
                for (int d = 0; d < NDB; ++d) xch[((wq * 16 + r) * 4 + d) * 64 + lane] = o[d][r] * a[r];
        }
        __syncthreads();
        if (grp == 0) {
            float ssq[16];
#pragma unroll
            for (int r = 0; r < 16; ++r) { float s = 0.f;
#pragma unroll
                for (int d = 0; d < NDB; ++d) { const float v = o[d][r] * a[r] - xch[((wq * 16 + r) * 4 + d) * 64 + lane]; o[d][r] = v; s += v * v; }
                ssq[r] = s; }
#pragma unroll
            for (int r = 0; r < 16; ++r) {
#pragma unroll
                for (int of = 1; of < 32; of <<= 1) ssq[r] += __shfl_xor(ssq[r], of);
            }
            float gs[NDB];
#pragma unroll
            for (int d = 0; d < NDB; ++d) gs[d] = subg[d * 32 + r32] * oml;
            ATT_LAS unsigned short* stg1 = (ATT_LAS unsigned short*)(lds + L_END + 64 + wq * 8192);
#pragma unroll
            for (int r = 0; r < 16; ++r) { const float rs = __builtin_amdgcn_rsqf(ssq[r] * (1.0f / 128.0f) + 1e-5f);
#pragma unroll
                for (int d = 0; d < NDB; ++d) stg1[crow(r, hi) * 128 + d * 32 + r32] = (unsigned short)(cvtpk(o[d][r] * rs * gs[d], 0.f) & 0xffffu); }
            asm volatile("s_waitcnt lgkmcnt(0)" ::: "memory");
#pragma unroll
            for (int i = 0; i < 8; ++i) { const int row = i * 4 + (lane >> 4), ch = lane & 15; const u32x4 v = *(const ATT_LAS u32x4*)(stg1 + row * 128 + ch * 8);
                *(u32x4*)(Y + (yrow0 + row) * 512 + hp * 128 + ch * 8) = v; }
        }
    }
    asm volatile("s_waitcnt lgkmcnt(0)\n\ts_barrier" ::: "memory");
}

__device__ __forceinline__ void unpack8(const u32x4 v, float (&f)[8]) { f[0] = __uint_as_float(v.x << 16); f[1] = __uint_as_float(v.x & 0xffff0000u); f[2] = __uint_as_float(v.y << 16); f[3] = __uint_as_float(v.y & 0xffff0000u);
    f[4] = __uint_as_float(v.z << 16); f[5] = __uint_as_float(v.z & 0xffff0000u); f[6] = __uint_as_float(v.w << 16); f[7] = __uint_as_float(v.w & 0xffff0000u); }
__device__ __forceinline__ void mixb_rows8(const unsigned short* __restrict__ Z, unsigned short* __restrict__ YB, int row0, int lane) {
    const int t0 = row0 & 4095, w = 2 << (lane >> 4);
    u32x4 v[23];
#pragma unroll
    for (int i = 0; i < 23; ++i) { const int t = t0 - 15 + i; v[i] = (u32x4){0u, 0u, 0u, 0u}; if (t >= 0) v[i] = *(const u32x4*)(Z + (size_t)(row0 - 15 + i) * ZP + 1536 + lane * 8); }
    float s[8];
#pragma unroll
    for (int c = 0; c < 8; ++c) s[c] = 0.f;
#pragma unroll
    for (int i = 0; i < 15; ++i) { if (i >= 16 - w) { float f[8]; unpack8(v[i], f);
#pragma unroll
        for (int c = 0; c < 8; ++c) s[c] += f[c]; } }
#pragma unroll
    for (int r = 0; r < 8; ++r) {
        float f[8]; unpack8(v[15 + r], f);
#pragma unroll
        for (int c = 0; c < 8; ++c) s[c] += f[c];
        const int t = t0 + r, n = (t + 1) < w ? (t + 1) : w; const float inv = 1.0f / (float)n;
        u32x4 o; o.x = cvtpk(s[0] * inv - f[0], s[1] * inv - f[1]); o.y = cvtpk(s[2] * inv - f[2], s[3] * inv - f[3]); o.z = cvtpk(s[4] * inv - f[4], s[5] * inv - f[5]); o.w = cvtpk(s[6] * inv - f[6], s[7] * inv - f[7]);
        *(u32x4*)(YB + (size_t)(row0 + r) * 512 + lane * 8) = o;
        float g[8]; const u32x4 old = (w == 2) ? v[14 + r] : (w == 4) ? v[12 + r] : (w == 8) ? v[8 + r] : v[r]; unpack8(old, g);
#pragma unroll
        for (int c = 0; c < 8; ++c) s[c] -= g[c];
    }
}
}
constexpr int NWAVES = 8;
constexpr size_t WS_W = 1536 * MiB;
constexpr size_t LW_WIN = 0;
constexpr size_t LW_WBR = 13 * MiB;
constexpr size_t LW_WOUT = 16 * MiB;
constexpr size_t LW_EGU = 18 * MiB;
constexpr size_t LW_EDN = 83 * MiB;
constexpr size_t LW_RW = 115 * MiB + 512 * 1024;
constexpr size_t LW_STRIDE = 116 * MiB;
constexpr size_t WS_MK_END = WS_W + 4 * LW_STRIDE;
constexpr size_t SM_CS = 7 * MiB;
constexpr size_t SM_BCNT = 8 * MiB;
constexpr int CW_BAR = 4096;

constexpr int RING_OFF = 0, RING_BYTES = 131072;
constexpr int EXTRA_OFF = RING_BYTES, EXTRA_BYTES = 15 * 1024;
constexpr int LDSCTL_OFF = EXTRA_OFF + EXTRA_BYTES, MISC_OFF = LDSCTL_OFF + 64;
constexpr int LDS_BYTES = 147456;

#define GAS __attribute__((address_space(1)))
#define LAS __attribute__((address_space(3)))
typedef float f32x4 __attribute__((ext_vector_type(4)));
typedef unsigned v4u __attribute__((ext_vector_type(4)));
typedef unsigned v2u __attribute__((ext_vector_type(2)));
typedef GAS unsigned gu32;
#define RLX_AGENT __ATOMIC_RELAXED, __HIP_MEMORY_SCOPE_AGENT

#define XB_TMO      128
#define XB_XCNT(j)  (256  + 64 * (j))
#define XB_XSUB(j)  (1280 + 64 * (j))
#define XB_XGEN(j)  (2304 + 64 * (j))
#define XB_TOP      3328
#define XB_TOPGEN   3392
#define XCD_BAR_WORDS 3456
#define XB_SPIN_CAP (1u << 18)
__device__ __forceinline__ unsigned xb_ld(unsigned* p)              { return __hip_atomic_load(p, __ATOMIC_RELAXED, __HIP_MEMORY_SCOPE_AGENT); }
__device__ __forceinline__ unsigned xb_add(unsigned* p, unsigned v) { return __hip_atomic_fetch_add(p, v, __ATOMIC_RELAXED, __HIP_MEMORY_SCOPE_AGENT); }
__device__ __forceinline__ unsigned xb_xcc_id() { return (unsigned)__builtin_amdgcn_s_getreg((3 << 11) | 20) & 0xFu; }
#define XB_SPIN(cond, bar) do { unsigned _sp = 0; while (cond) { __builtin_amdgcn_s_sleep(1); \
    if ((++_sp & 255u) == 0u) { if (xb_ld(&(bar)[XB_TMO])) break; if (_sp > XB_SPIN_CAP) { atomicAdd(&(bar)[XB_TMO], 1u); break; } } } } while (0)
struct XcdBarrier { unsigned* bar; unsigned x; volatile LAS unsigned* st; };
__device__ __forceinline__ XcdBarrier xcd_barrier_post(unsigned* bar, volatile LAS unsigned* st) {
    XcdBarrier b; b.bar = bar; b.x = xb_xcc_id(); b.st = st;
    if (threadIdx.x == 0) (void)xb_add(&bar[XB_XCNT(b.x)], 1u);
    return b;
}
__device__ __forceinline__ void xcd_barrier_complete(unsigned* bar, unsigned x, unsigned& nloc, unsigned& nx) {
    const unsigned G = gridDim.x * gridDim.y * gridDim.z;
    unsigned sum, cnt, mine, sp = 0u;
    for (;;) {
        sum = 0u; cnt = 0u; mine = 0u;
#pragma unroll
        for (unsigned j = 0; j < 16; ++j) { const unsigned c = xb_ld(&bar[XB_XCNT(j)]); sum += c; cnt += (c > 0u) ? 1u : 0u; mine = (j == x) ? c : mine; }
        if (sum == G) break;
        __builtin_amdgcn_s_sleep(1);
        if ((++sp & 255u) == 0u) { if (xb_ld(&bar[XB_TMO])) break; if (sp > XB_SPIN_CAP) { atomicAdd(&bar[XB_TMO], 1u); break; } }
    }
    nloc = mine > 0u ? mine : 1u; nx = cnt > 0u ? cnt : 1u;
}
__device__ __forceinline__ void xcd_barrier(const XcdBarrier& b) {
    asm volatile("s_waitcnt vmcnt(0)" ::: "memory");
    __syncthreads();
    if (threadIdx.x == 0) {
        unsigned* bar = b.bar;
        __builtin_amdgcn_s_waitcnt(0);
        unsigned nloc = b.st[0], nx = b.st[1];
        if (nloc == 0u) { xcd_barrier_complete(bar, b.x, nloc, nx); b.st[0] = nloc; b.st[1] = nx; }
        const unsigned old = xb_add(&bar[XB_XSUB(b.x)], 1u);
        const unsigned gen = old / nloc;
        if (old + 1u == (gen + 1u) * nloc) {
            __builtin_amdgcn_fence(__ATOMIC_RELEASE, "agent");
            asm volatile("s_waitcnt vmcnt(0)" ::: "memory");
            const unsigned og = xb_add(&bar[XB_TOP], 1u);
            const unsigned tg = og / nx;
            if (og + 1u == (tg + 1u) * nx) xb_add(&bar[XB_TOPGEN], 1u);
            else XB_SPIN(xb_ld(&bar[XB_TOPGEN]) == tg, bar);
            __builtin_amdgcn_fence(__ATOMIC_ACQUIRE, "agent");
            xb_add(&bar[XB_XGEN(b.x)], 1u);
            asm volatile("s_waitcnt vmcnt(0)" ::: "memory");
        } else {
            XB_SPIN(xb_ld(&bar[XB_XGEN(b.x)]) == gen, bar);
            __builtin_amdgcn_fence(__ATOMIC_ACQUIRE, "agent");
            asm volatile("s_waitcnt vmcnt(0)" ::: "memory");
        }
    }
    __syncthreads();
}

struct MkArgs { const float* in[24]; float* out; unsigned char* ws; int ph_lo, ph_hi, li, pad; };
struct Frame {
    LAS unsigned char* lds; volatile LAS unsigned* MISC;
    int tid, lane, wave, vcu, G;
};
__device__ __forceinline__ float wave_sum(float v) {
#pragma unroll
    for (int o = 1; o < 64; o <<= 1) v += __shfl_xor(v, o);
    return v;
}
__device__ __forceinline__ unsigned pk2(float lo, float hi) { unsigned r; asm("v_cvt_pk_bf16_f32 %0, %1, %2" : "=v"(r) : "v"(lo), "v"(hi)); return r; }

__device__ __forceinline__ void conv_store(const float (&v)[64], unsigned short* drow) {
#pragma unroll
    for (int c = 0; c < 8; ++c) { v4u o; o.x = pk2(v[8 * c], v[8 * c + 1]); o.y = pk2(v[8 * c + 2], v[8 * c + 3]); o.z = pk2(v[8 * c + 4], v[8 * c + 5]); o.w = pk2(v[8 * c + 6], v[8 * c + 7]); *(v4u*)(drow + 8 * c) = o; }
}
__device__ __forceinline__ void conv_item_fold(const float* __restrict__ w_in_l, const float* __restrict__ pool_w_l, const float* __restrict__ pool_scale_l, unsigned short* __restrict__ WinT, int kb16, int nbj, int lane, LAS float* wl) {
    const int j = nbj * 64 + lane, g = __builtin_amdgcn_readfirstlane(j >> 7), d = j & 127, k0 = kb16 * 16; float v[16];
#pragma unroll
    for (int i = 0; i < 16; ++i) v[i] = 0.f;
    const float* pw = pool_w_l + (size_t)g * 128 * 128 + d;
    const float* wbase = w_in_l + (size_t)k0 * DIN + C_UB + g * 128;
    { f32x4 wv[8];
#pragma unroll
      for (int q = 0; q < 8; ++q) wv[q] = *(const f32x4*)(wbase + (size_t)(2 * q + (lane >> 5)) * DIN + (lane & 31) * 4);
#pragma unroll
      for (int q = 0; q < 8; ++q) { const int i = 2 * q + (lane >> 5), c0 = (lane & 31) * 4;
#pragma unroll
          for (int e = 0; e < 4; ++e) wl[(c0 + e) * 16 + i] = wv[q][e]; } }
    asm volatile("s_waitcnt lgkmcnt(0)" ::: "memory");
#pragma clang loop unroll(disable)
    for (int cb = 0; cb < 128; cb += 32) {
        float p[32];
#pragma unroll
        for (int c = 0; c < 32; ++c) p[c] = pw[(size_t)(cb + c) * 128];
#pragma unroll
        for (int c = 0; c < 32; ++c) { const LAS f32x4* wr4 = (const LAS f32x4*)(wl + (cb + c) * 16);
            const f32x4 w0 = wr4[0], w1 = wr4[1], w2 = wr4[2], w3 = wr4[3];
#pragma unroll
            for (int e = 0; e < 4; ++e) { v[e] += w0[e] * p[c]; v[4 + e] += w1[e] * p[c]; v[8 + e] += w2[e] * p[c]; v[12 + e] += w3[e] * p[c]; } }
    }
    const float ps = pool_scale_l[j];
    unsigned short* drow = WinT + (size_t)(C_UB + j) * DM + k0;
#pragma unroll
    for (int c = 0; c < 2; ++c) { v4u o; o.x = pk2(v[8 * c] * ps, v[8 * c + 1] * ps); o.y = pk2(v[8 * c + 2] * ps, v[8 * c + 3] * ps); o.z = pk2(v[8 * c + 4] * ps, v[8 * c + 5] * ps); o.w = pk2(v[8 * c + 6] * ps, v[8 * c + 7] * ps); *(v4u*)(drow + 8 * c) = o; }
}
__device__ __forceinline__ void conv_item_router(const float* __restrict__ rw_l, unsigned short* __restrict__ hi, unsigned short* __restrict__ lo, int kb, int lane) {
    const int k0 = kb * 64; float v[64], w[64];
#pragma unroll
    for (int i = 0; i < 64; ++i) { const float x = rw_l[(size_t)(k0 + i) * 64 + lane]; const float h = __uint_as_float(pk2(x, 0.f) << 16); v[i] = h; w[i] = x - h; }
    conv_store(v, hi + (size_t)lane * DM + k0); conv_store(w, lo + (size_t)lane * DM + k0);
}
constexpr int IT_RW = 16;
constexpr int WT_W256 = 16 * 24, WT_BR = 8 * 4, WT_WOUT = 16 * 4, WT_EGU = 64 * 16 * 2, WT_EDN = 64 * 4 * 4, WT_SGU = 16 * 2, WT_SDN = 4 * 4;
constexpr int WT_LAYER = WT_W256 + 3 * WT_BR + WT_WOUT + WT_EGU + WT_EDN + WT_SGU + WT_SDN;
struct ConvTile { const float* src; unsigned short* dst; int N, K, n0, perm; };
__device__ __forceinline__ ConvTile conv_tile_decode(const MkArgs& a, unsigned char* ws, int it) {
    const int l = it / WT_LAYER; int r = it % WT_LAYER; unsigned char* lw = ws + WS_W + (size_t)l * LW_STRIDE;
    ConvTile t; const float* W; unsigned short* WT; int kb, nb; t.perm = 0;
    if (r < WT_W256) { kb = r % 16; nb = r / 16; if (nb >= 6) nb += 2; W = a.in[1] + (size_t)l * DM * DIN; t.K = DM; t.N = DIN; WT = (unsigned short*)(lw + LW_WIN); }
    else if ((r -= WT_W256) < 3 * WT_BR) { const int br = r / WT_BR, q = r % WT_BR; W = a.in[10] + (size_t)l * 512 * DM; if (br == 1) W = a.in[11] + (size_t)l * 512 * DM; if (br == 2) W = a.in[12] + (size_t)l * 512 * DM; t.K = 512; t.N = DM; WT = (unsigned short*)(lw + LW_WBR + (size_t)br * MiB); kb = q % 8; nb = q / 8; }
    else if ((r -= 3 * WT_BR) < WT_WOUT) { W = a.in[13] + (size_t)l * DM * DM; t.K = DM; t.N = DM; WT = (unsigned short*)(lw + LW_WOUT); kb = r % 16; nb = r / 16; }
    else if ((r -= WT_WOUT) < WT_EGU) { const int e = r / 32, q = r % 32; W = a.in[18] + ((size_t)l * NEXP + e) * DM * 512; t.K = DM; t.N = 512; WT = (unsigned short*)(lw + LW_EGU) + (size_t)e * 512 * DM; kb = q % 16; nb = q / 16; t.perm = 1; }
    else if ((r -= WT_EGU) < WT_EDN) { const int e = r / 16, q = r % 16; W = a.in[19] + ((size_t)l * NEXP + e) * EDIM * DM; t.K = EDIM; t.N = DM; WT = (unsigned short*)(lw + LW_EDN) + (size_t)e * DM * EDIM; kb = q % 4; nb = q / 4; }
    else if ((r -= WT_EDN) < WT_SGU) { W = a.in[20] + (size_t)l * DM * 512; t.K = DM; t.N = 512; WT = (unsigned short*)(lw + LW_EGU) + (size_t)NEXP * 512 * DM; kb = r % 16; nb = r / 16; t.perm = 1; }
    else { r -= WT_SGU; W = a.in[21] + (size_t)l * EDIM * DM; t.K = EDIM; t.N = DM; WT = (unsigned short*)(lw + LW_EDN) + (size_t)NEXP * DM * EDIM; kb = r % 4; nb = r / 4; }
    t.n0 = nb * 256; t.src = W + (size_t)(kb * 64) * t.N + t.n0; t.dst = WT + kb * 64;
    return t;
}
__device__ __forceinline__ void conv_wg_loop(const Frame& F, const MkArgs& a, unsigned char* ws, int first, int stride, int count) {
    constexpr int TP = 144;
    const int lane = F.lane, w = F.wave;
#define CONV_MAP(j) (j)
#define CONV_LOAD(v, t) do { _Pragma("unroll") for (int i_ = 0; i_ < 8; ++i_) v[i_] = __builtin_nontemporal_load((const f32x4*)((t).src + (size_t)(8 * w + i_) * (t).N) + lane); } while (0)
#define CONV_TO_LDS(v, T) do { _Pragma("unroll") for (int j_ = 0; j_ < 4; ++j_) { v4u o_; o_.x = pk2(v[0][j_], v[1][j_]); o_.y = pk2(v[2][j_], v[3][j_]); o_.z = pk2(v[4][j_], v[5][j_]); o_.w = pk2(v[6][j_], v[7][j_]); \
        *(LAS v4u*)((T) + (4 * lane + j_) * TP + 16 * w) = o_; } } while (0)
#define CONV_STORE(tc, T) do { _Pragma("unroll") for (int i_ = 0; i_ < 4; ++i_) { const int nr_ = 32 * w + 8 * i_ + (lane >> 3), c_ = lane & 7; const v4u o_ = *(const LAS v4u*)((T) + nr_ * TP + 16 * c_); \
        const int n_ = (tc).n0 + nr_; int drow_ = n_; if ((tc).perm) { const int half_ = n_ >> 8, j_ = n_ & 255; drow_ = 256 * (j_ >> 7) + 128 * half_ + (j_ & 127); } \
        __builtin_nontemporal_store(o_, (v4u*)((tc).dst + (size_t)drow_ * (tc).K + 8 * c_)); } } while (0)
    int it = first; if (it >= count) return;
    ConvTile ta = conv_tile_decode(a, ws, CONV_MAP(it)), tb = ta; f32x4 va[8], vb[8];
    CONV_LOAD(va, ta);
    bool hb = it + stride < count;
    if (hb) { tb = conv_tile_decode(a, ws, CONV_MAP(it + stride)); CONV_LOAD(vb, tb); }
    LAS unsigned char* T0 = F.lds; LAS unsigned char* T1 = F.lds + 256 * TP;
    for (;;) {
        CONV_TO_LDS(va, T0);
        __syncthreads();
        const ConvTile tca = ta; const int ia2 = it + 2 * stride; const bool ha = ia2 < count;
        if (ha) { ta = conv_tile_decode(a, ws, CONV_MAP(ia2)); CONV_LOAD(va, ta); }
        CONV_STORE(tca, T0);
        if (!hb) break;
        CONV_TO_LDS(vb, T1);
        __syncthreads();
        const ConvTile tcb = tb; const int ib2 = it + 3 * stride; hb = ib2 < count;
        if (hb) { tb = conv_tile_decode(a, ws, CONV_MAP(ib2)); CONV_LOAD(vb, tb); }
        CONV_STORE(tcb, T1);
        if (!ha) break;
        it = ia2;
    }
    __syncthreads();
#undef CONV_MAP
#undef CONV_LOAD
#undef CONV_TO_LDS
#undef CONV_STORE
}
__device__ __forceinline__ void p0_prologue(const Frame& F, const MkArgs& a) {
    const int gw = F.vcu * NWAVES + F.wave, NGW = F.G * NWAVES, lane = F.lane;
    unsigned char* ws = a.ws;
    const int n_first = 3 + (F.vcu * 13) % 48;
    {
    conv_wg_loop(F, a, ws, F.vcu, F.G, (F.vcu + n_first * F.G) < DEPTH * WT_LAYER ? (F.vcu + n_first * F.G) : DEPTH * WT_LAYER);
    for (int it = gw; it < DEPTH * IT_RW; it += NGW) { const int l = it / IT_RW, r = it % IT_RW; unsigned char* lw = ws + WS_W + (size_t)l * LW_STRIDE;
        conv_item_router(a.in[16] + (size_t)l * DM * NEXP, (unsigned short*)(lw + LW_RW), (unsigned short*)(lw + LW_RW) + (size_t)NEXP * DM, r, lane); }
    }
    {
    for (int it = gw; it < DEPTH * 64 * 8; it += NGW) { const int l = it >> 9, kb16 = (it >> 3) & 63, nbj = it & 7;
        conv_item_fold(a.in[1] + (size_t)l * DM * DIN, a.in[3] + (size_t)l * 4 * 128 * 128, a.in[4] + (size_t)l * 512, (unsigned short*)(ws + WS_W + (size_t)l * LW_STRIDE + LW_WIN), kb16, nbj, lane, (LAS float*)(F.lds + F.wave * 8192)); }
    }
    {
    unsigned short* xb = (unsigned short*)(ws + WS_XB);
    for (int m = gw; m < NTOK; m += 4 * NGW) {
        f32x4 v[4][4];
#pragma unroll
        for (int r = 0; r < 4; ++r) { const int row = m + r * NGW;
#pragma unroll
            for (int j = 0; j < 4; ++j) v[r][j] = (row < NTOK) ? ((const f32x4*)(a.in[0] + (size_t)row * DM) + lane)[64 * j] : (f32x4){0.f, 0.f, 0.f, 0.f}; }
#pragma unroll
        for (int r = 0; r < 4; ++r) { const int row = m + r * NGW; if (row < NTOK) { v2u* bo = (v2u*)(xb + (size_t)row * DM) + lane;
#pragma unroll
            for (int j = 0; j < 4; ++j) { v2u o; o.x = pk2(v[r][j].x, v[r][j].y); o.y = pk2(v[r][j].z, v[r][j].w); bo[64 * j] = o; } } } }
    float* cs = (float*)(ws + WS_SMALL + SM_CS);
    for (int i = gw * 64 + lane; i < SEQ * 8; i += NGW * 64) { const int t = i >> 3, ii = i & 7; const float inv = powf(500000.0f, -(float)(2 * ii) / 16.0f); const float ang = (float)t * inv; cs[t * 16 + ii] = cosf(ang); cs[t * 16 + 8 + ii] = sinf(ang); }
    if (gw < DEPTH) { const int l = gw; const float s1 = wave_sum(a.in[5][l * 64 + lane] * a.in[6][l * 64 + lane]), s2 = wave_sum(a.in[7][l * 64 + lane] * a.in[8][l * 64 + lane]);
        if (lane == 0) ((float*)(ws + WS_SMALL + SM_LAM))[l] = expf(s1) - expf(s2); }
    }
    __syncthreads();
    conv_wg_loop(F, a, ws, F.vcu + n_first * F.G, F.G, DEPTH * WT_LAYER);
}

__device__ __forceinline__ void ln1_router_block(const Frame& F, int tb, unsigned short* xb, const float* __restrict__ g, const float* __restrict__ bta,
                                                 const unsigned short* __restrict__ rwhi, const unsigned short* __restrict__ rwlo, const float* __restrict__ rbias,
                                                 int* __restrict__ idx, float* __restrict__ wts, int* __restrict__ rank, int* __restrict__ bcnt) {
    typedef short bf16x8 __attribute__((ext_vector_type(8)));
    LAS float* lgp = (LAS float*)(F.lds + 1024);
    LAS float* scs = (LAS float*)(F.lds + 1024 + 16384);
    LAS float* chs = scs + 64 * 65;
    LAS float* gl = (LAS float*)(F.lds + 131072);
    LAS float* bl = gl + 1024;
    LAS float* stats = bl + 1024;
    LAS float* rbL = stats + 128;
    LAS int* hist = (LAS int*)(rbL + 64);
    const int lane = F.lane, w = F.wave, tid = F.tid;
    if (tid < 64) hist[tid] = 0;
    for (int i = tid; i < DM; i += NWAVES * 64) { gl[i] = g[i]; bl[i] = bta[i]; }
    if (tid < NEXP) rbL[tid] = rbias[tid];
    { const unsigned short* wsrc = rwhi + (size_t)(lane & 15) * DM + (lane >> 4) * 8;
#pragma unroll
      for (int j = 0; j < 16; ++j) { const int pi = w * 16 + j, sK = pi >> 2, nbW = pi & 3;
          __builtin_amdgcn_global_load_lds((const unsigned*)(wsrc + (size_t)(nbW * 16) * DM + sK * 32), (LAS unsigned*)(F.lds + pi * 1024), 16, 0, 0); } }
    for (int rr = 0; rr < 8; rr += 2) { const int row = tb * 64 + w * 8 + rr; const v4u* xr = (const v4u*)(xb + (size_t)row * DM) + lane; float v[2][16]; float s0 = 0.f, s1 = 0.f;
        { const v4u a0 = xr[0], a1 = xr[64], c0 = xr[128], c1 = xr[192];
#define UNP8(dst, o, q) do { dst[o] = __uint_as_float(q.x << 16); dst[o + 1] = __uint_as_float(q.x & 0xffff0000u); dst[o + 2] = __uint_as_float(q.y << 16); dst[o + 3] = __uint_as_float(q.y & 0xffff0000u); \
            dst[o + 4] = __uint_as_float(q.z << 16); dst[o + 5] = __uint_as_float(q.z & 0xffff0000u); dst[o + 6] = __uint_as_float(q.w << 16); dst[o + 7] = __uint_as_float(q.w & 0xffff0000u); } while (0)
          UNP8(v[0], 0, a0); UNP8(v[0], 8, a1); UNP8(v[1], 0, c0); UNP8(v[1], 8, c1);
#undef UNP8
        }
#pragma unroll
        for (int j = 0; j < 16; ++j) { s0 += v[0][j]; s1 += v[1][j]; }
        const float m0 = wave_sum(s0) * (1.f / DM), m1 = wave_sum(s1) * (1.f / DM); float q0 = 0.f, q1 = 0.f;
#pragma unroll
        for (int j = 0; j < 16; ++j) { const float d0 = v[0][j] - m0, d1 = v[1][j] - m1; q0 += d0 * d0; q1 += d1 * d1; }
        const float r0 = rsqrtf(wave_sum(q0) * (1.f / DM) + LN_EPS), r1 = rsqrtf(wave_sum(q1) * (1.f / DM) + LN_EPS);
        if (lane == 0) { stats[(w * 8 + rr) * 2] = m0; stats[(w * 8 + rr) * 2 + 1] = r0; stats[(w * 8 + rr) * 2 + 2] = m1; stats[(w * 8 + rr) * 2 + 3] = r1; } }
    asm volatile("s_waitcnt vmcnt(0)" ::: "memory");
    __syncthreads();
    const int tq = w & 3, kh = w >> 2, trow = lane & 15, kg = lane >> 4;
    const int row = tb * 64 + tq * 16 + trow;
    const float mean = stats[(tq * 16 + trow) * 2], rstd = stats[(tq * 16 + trow) * 2 + 1];
    f32x4 acc[4];
#pragma unroll
    for (int nb = 0; nb < 4; ++nb) acc[nb] = (f32x4){0.f, 0.f, 0.f, 0.f};
    v4u hbs[16];
#pragma unroll
    for (int g2 = 0; g2 < 16; ++g2) hbs[g2] = *(const v4u*)(xb + (size_t)row * DM + kh * 512 + g2 * 32 + kg * 8);
#pragma unroll
    for (int sb = 0; sb < 2; ++sb) {
#pragma unroll
        for (int s = 0; s < 8; ++s) {
            const int k0 = kh * 512 + (sb * 8 + s) * 32 + kg * 8;
            bf16x8 wc[4];
#pragma unroll
            for (int nb = 0; nb < 4; ++nb) wc[nb] = *(const LAS bf16x8*)(F.lds + ((kh * 16 + sb * 8 + s) * 4 + nb) * 1024 + lane * 16);
            const v4u q = hbs[sb * 8 + s];
            const f32x4 x0 = (f32x4){__uint_as_float(q.x << 16), __uint_as_float(q.x & 0xffff0000u), __uint_as_float(q.y << 16), __uint_as_float(q.y & 0xffff0000u)};
            const f32x4 x1 = (f32x4){__uint_as_float(q.z << 16), __uint_as_float(q.z & 0xffff0000u), __uint_as_float(q.w << 16), __uint_as_float(q.w & 0xffff0000u)};
            const f32x4 g0 = *(const LAS f32x4*)(gl + k0), g1 = *(const LAS f32x4*)(gl + k0 + 4), b0 = *(const LAS f32x4*)(bl + k0), b1 = *(const LAS f32x4*)(bl + k0 + 4);
            const f32x4 y0 = (x0 - mean) * rstd * g0 + b0, y1 = (x1 - mean) * rstd * g1 + b1;
            v4u hb; hb.x = pk2(y0.x, y0.y); hb.y = pk2(y0.z, y0.w); hb.z = pk2(y1.x, y1.y); hb.w = pk2(y1.z, y1.w);
            hbs[sb * 8 + s] = hb;
            v4u lb; lb.x = pk2(y0.x - __uint_as_float(hb.x << 16), y0.y - __uint_as_float(hb.x & 0xffff0000u)); lb.y = pk2(y0.z - __uint_as_float(hb.y << 16), y0.w - __uint_as_float(hb.y & 0xffff0000u));
            lb.z = pk2(y1.x - __uint_as_float(hb.z << 16), y1.y - __uint_as_float(hb.z & 0xffff0000u)); lb.w = pk2(y1.z - __uint_as_float(hb.w << 16), y1.w - __uint_as_float(hb.w & 0xffff0000u));
            const bf16x8 xh = __builtin_bit_cast(bf16x8, hb), xl = __builtin_bit_cast(bf16x8, lb);
#pragma unroll
            for (int nb = 0; nb < 4; ++nb) acc[nb] = __builtin_amdgcn_mfma_f32_16x16x32_bf16(wc[nb], xh, acc[nb], 0, 0, 0);
#pragma unroll
            for (int nb = 0; nb < 4; ++nb) acc[nb] = __builtin_amdgcn_mfma_f32_16x16x32_bf16(wc[nb], xl, acc[nb], 0, 0, 0);
        }
    }
#pragma unroll
    for (int g2 = 0; g2 < 16; ++g2) __builtin_nontemporal_store(hbs[g2], (v4u*)(xb + (size_t)row * DM + kh * 512 + g2 * 32 + kg * 8));
#define LN_LBAR() asm volatile("s_waitcnt lgkmcnt(0)\n\ts_barrier" ::: "memory")
    LN_LBAR();
    if (kh == 1) {
#pragma unroll
        for (int nb = 0; nb < 4; ++nb)
#pragma unroll
            for (int r = 0; r < 4; ++r) lgp[(tq * 16 + trow) * 64 + nb * 16 + kg * 4 + r] = acc[nb][r];
    }
    LN_LBAR();
    if (kh == 0) {
#pragma unroll
        for (int nb = 0; nb < 4; ++nb)
#pragma unroll
            for (int r = 0; r < 4; ++r) { const int e = nb * 16 + kg * 4 + r; const float lgt = acc[nb][r] + lgp[(tq * 16 + trow) * 64 + e]; const float sg = 1.f / (1.f + expf(-lgt));
                scs[(tq * 16 + trow) * 65 + e] = sg; chs[(tq * 16 + trow) * 65 + e] = sg + rbL[e]; }
    }
    LN_LBAR();
    {
        const int tl = lane >> 3, gI = lane & 7, tloc = w * 8 + tl, tok = tb * 64 + tloc;
        float c[8], s[8];
#pragma unroll
        for (int j = 0; j < 8; ++j) { c[j] = chs[tloc * 65 + gI * 8 + j]; s[j] = scs[tloc * 65 + gI * 8 + j]; }
        float a = -INFINITY, b2 = -INFINITY;
#pragma unroll
        for (int j = 0; j < 8; ++j) { if (c[j] > a) { b2 = a; a = c[j]; } else if (c[j] > b2) b2 = c[j]; }
        const float gsum = a + b2; int cnt = 0;
#pragma unroll
        for (int d = 1; d < 8; ++d) { const int og = (gI + d) & 7; const float o = __shfl(gsum, (lane & ~7) | og); cnt += (o > gsum || (o == gsum && og < gI)) ? 1 : 0; }
        if (cnt >= 4) {
#pragma unroll
            for (int j = 0; j < 8; ++j) c[j] = -INFINITY; }
        int id[8]; float wv[8]; float sum = 0.f;
#pragma unroll
        for (int n = 0; n < 8; ++n) {
            float bv = c[0]; int be = 0;
#pragma unroll
            for (int j = 1; j < 8; ++j) { if (c[j] > bv) { bv = c[j]; be = j; } }
            be += gI * 8;
#pragma unroll
            for (int mk = 1; mk < 8; mk <<= 1) { const float v2 = __shfl_xor(bv, mk); const int e2 = __shfl_xor(be, mk); const bool tk = (v2 > bv) || (v2 == bv && e2 < be); bv = tk ? v2 : bv; be = tk ? e2 : be; }
            const bool own = (be >> 3) == gI; float sv = 0.f;
#pragma unroll
            for (int j = 0; j < 8; ++j) { const bool hit = own && ((be & 7) == j); sv = hit ? s[j] : sv; c[j] = hit ? -INFINITY : c[j]; }
            sv = __shfl(sv, (lane & ~7) | (be >> 3));
            id[n] = be; wv[n] = sv; sum += sv;
        }
        const float rs = ROUTED_SCALE / sum; int myid = id[0]; float myw = wv[0];
#pragma unroll
        for (int n = 1; n < 8; ++n) { myid = (gI == n) ? id[n] : myid; myw = (gI == n) ? wv[n] : myw; }
        idx[tok * 8 + gI] = myid; wts[tok * 8 + gI] = myw * rs;
        rank[tok * 8 + gI] = __hip_atomic_fetch_add((LAS int*)&hist[myid], 1, __ATOMIC_RELAXED, __HIP_MEMORY_SCOPE_WORKGROUP);
    }
    LN_LBAR();
    if (tid < 64) bcnt[tb * 64 + tid] = hist[tid];
    LN_LBAR();
#undef LN_LBAR
}

__device__ __forceinline__ void scatter_block(const Frame& F, int tb, const int* __restrict__ bcnt, const int* __restrict__ idx, const int* __restrict__ rank, int* __restrict__ pos, int* __restrict__ rowtok,
                                              int* __restrict__ off_g, int* __restrict__ tile_expert, int* __restrict__ ntiles, bool writer) {
    LAS int* tot = (LAS int*)(F.lds);
    LAS int* pre = tot + 64;
    LAS int* off = pre + 64;
    const int tid = F.tid;
    { LAS int* part = off + 80;
      const int e = tid & 63, pt = tid >> 6; int t = 0, p = 0;
      int cv[32];
#pragma unroll
      for (int j = 0; j < 32; ++j) cv[j] = bcnt[(pt * 32 + j) * 64 + e];
#pragma unroll
      for (int j = 0; j < 32; ++j) { t += cv[j]; p += (pt * 32 + j < tb) ? cv[j] : 0; }
      part[pt * 64 + e] = t; part[512 + pt * 64 + e] = p; }
    __syncthreads();
    if (tid < 64) { int t = 0, p = 0;
#pragma unroll
      for (int pt = 0; pt < 8; ++pt) { t += (off + 80)[pt * 64 + tid]; p += (off + 80)[512 + pt * 64 + tid]; } tot[tid] = t; pre[tid] = p;
      const int padded = ((t + 255) >> 8) * 256; int inc = padded;
#pragma unroll
      for (int o = 1; o < 64; o <<= 1) { const int v = __shfl_up(inc, o); inc += (tid >= o) ? v : 0; }
      off[tid] = inc - padded; if (tid == 63) off[NEXP] = inc; }
    __syncthreads();
    if (writer) { const int ntr = off[NEXP] >> 8;
        if (tid <= NEXP) off_g[tid] = off[tid];
        for (int t = tid; t < ntr + NTOK / 256; t += NWAVES * 64) { int e = NEXP; if (t < ntr) { e = 0; while (off[e + 1] <= t * 256) ++e; } tile_expert[t] = e; }
        if (tid == 0) *ntiles = ntr + NTOK / 256; }
    { const int i = tb * 512 + tid; const int e = idx[i]; const int p = off[e] + pre[e] + rank[i]; pos[i] = p; rowtok[p] = i >> 3; }
    if (tid < 64) rowtok[off[NEXP] + tb * 64 + tid] = tb * 64 + tid;
    __syncthreads();
}

constexpr float YE_SCALE = 32.f;
typedef float f32x2 __attribute__((ext_vector_type(2)));
template <int NR>
__device__ __forceinline__ void combine_rows(const int (&rows)[NR], int lane, float* __restrict__ outf, unsigned short* xb, const unsigned short* __restrict__ YE, const int* __restrict__ pos, const float* __restrict__ wts,
                                             int shared_base, const float* __restrict__ g, const float* __restrict__ bta, float alpha) {
    f32x4 v[NR][4]; float s[NR];
    int pr[NR][9]; float wr[NR][9];
#pragma unroll
    for (int r = 0; r < NR; ++r) { s[r] = 0.f;
#pragma unroll
        for (int k = 0; k < 8; ++k) { pr[r][k] = pos[rows[r] * 8 + k]; wr[r][k] = wts[rows[r] * 8 + k] * (1.f / YE_SCALE); }
        pr[r][8] = shared_base + rows[r]; wr[r][8] = 1.f / YE_SCALE; }
#pragma unroll
    for (int j = 0; j < 4; ++j) {
        f32x4 y[NR]; v2u xq[NR];
#pragma unroll
        for (int r = 0; r < NR; ++r) { y[r] = (f32x4){0.f, 0.f, 0.f, 0.f}; xq[r] = ((const v2u*)(xb + (size_t)rows[r] * DM))[64 * j + lane]; }
#pragma unroll
        for (int k = 0; k < 9; ++k)
#pragma unroll
            for (int r = 0; r < NR; ++r) { const unsigned u = ((const unsigned*)((const unsigned char*)YE + (size_t)pr[r][k] * DM))[64 * j + lane];
                const f32x2 lo2 = __builtin_amdgcn_cvt_pk_f32_fp8((int)u, false), hi2 = __builtin_amdgcn_cvt_pk_f32_fp8((int)u, true);
                y[r].x += wr[r][k] * lo2[0]; y[r].y += wr[r][k] * lo2[1]; y[r].z += wr[r][k] * hi2[0]; y[r].w += wr[r][k] * hi2[1]; }
#pragma unroll
        for (int r = 0; r < NR; ++r) { const v2u q = xq[r]; const f32x4 x = {__uint_as_float(q.x << 16), __uint_as_float(q.x & 0xffff0000u), __uint_as_float(q.y << 16), __uint_as_float(q.y & 0xffff0000u)};
            v[r][j] = x * alpha + y[r]; s[r] += (v[r][j].x + v[r][j].y) + (v[r][j].z + v[r][j].w); }
    }
    float mean[NR], rstd[NR];
#pragma unroll
    for (int r = 0; r < NR; ++r) mean[r] = wave_sum(s[r]) * (1.f / DM);
#pragma unroll
    for (int r = 0; r < NR; ++r) { float q = 0.f;
#pragma unroll
        for (int j = 0; j < 4; ++j) { v[r][j] = v[r][j] - mean[r]; q += (v[r][j].x * v[r][j].x + v[r][j].y * v[r][j].y) + (v[r][j].z * v[r][j].z + v[r][j].w * v[r][j].w); }
        rstd[r] = q; }
#pragma unroll
    for (int r = 0; r < NR; ++r) rstd[r] = rsqrtf(wave_sum(rstd[r]) * (1.f / DM) + LN_EPS);
#pragma unroll
    for (int j = 0; j < 4; ++j) { const f32x4 gg = ((const f32x4*)g)[64 * j + lane], bb = ((const f32x4*)bta)[64 * j + lane];
#pragma unroll
        for (int r = 0; r < NR; ++r) { const f32x4 o = v[r][j] * rstd[r] * gg + bb;
            if (outf) __builtin_nontemporal_store(o, (f32x4*)(outf + (size_t)rows[r] * DM) + 64 * j + lane);
            else { v2u ob; ob.x = pk2(o.x, o.y); ob.y = pk2(o.z, o.w); __builtin_nontemporal_store(ob, (v2u*)(xb + (size_t)rows[r] * DM) + 64 * j + lane); } } }
}

__device__ __forceinline__ int group_setup(const Frame& F, int c, int NT, const int* __restrict__ tile_expert, const int* __restrict__ ntiles_p, const int* __restrict__ rowtok, bool gather) {
    LAS int* ul = (LAS int*)(F.lds + EXTRA_OFF);
    LAS int* rt = (LAS int*)(F.lds + EXTRA_OFF + 256);
    const int total = (*ntiles_p) * NT;
    int nu = c < total ? (total - c + F.G - 1) / F.G : 0; if (nu > (gather ? 8 : 16)) nu = gather ? 8 : 16;
    if (F.tid < nu) { const int L = F.tid * F.G + c; const int tile = L / NT; ul[4 * F.tid] = tile; ul[4 * F.tid + 1] = L % NT; ul[4 * F.tid + 2] = tile_expert[tile]; ul[4 * F.tid + 3] = 0; }
    if (gather) { for (int i = F.tid; i < nu * 256; i += NWAVES * 64) { const int u = i >> 8; const int L = u * F.G + c; rt[i] = rowtok[(L / NT) * 256 + (i & 255)]; } }
    __syncthreads();
    return nu;
}

constexpr int PH_PER_LAYER = 9, N_PHASES = 1 + DEPTH * PH_PER_LAYER;
__global__ void __launch_bounds__(NWAVES * 64, 2) mk_fwd(MkArgs args) {
    extern __shared__ __attribute__((aligned(16))) unsigned char lds_raw[];
    Frame F;
    F.lds = (LAS unsigned char*)lds_raw;
    F.MISC = (volatile LAS unsigned*)(F.lds + MISC_OFF);
    F.tid = threadIdx.x; F.lane = F.tid & 63; F.wave = __builtin_amdgcn_readfirstlane(F.tid >> 6);
    F.G = gridDim.x; { const int bx = blockIdx.x; F.vcu = (F.G % 8 == 0) ? (bx % 8) * (F.G / 8) + bx / 8 : bx; }
    unsigned char* ws = args.ws;
    gu32* ctl = (gu32*)(ws + WS_CTL);
    for (int u = F.tid; u < (LDS_BYTES - LDSCTL_OFF) / 4; u += NWAVES * 64) ((LAS unsigned*)(F.lds + LDSCTL_OFF))[u] = 0u;
    __syncthreads();
    XcdBarrier bar = xcd_barrier_post((unsigned*)(ctl + CW_BAR) + args.li * 4096, F.MISC + 8);
    const int lo = args.ph_lo, hi = args.ph_hi;
#define IN(k) (lo <= (k) && (k) < hi)
#define RELAUNDER() do { int t_ = threadIdx.x; asm volatile("" : "+v"(t_)); F.tid = t_; F.lane = t_ & 63; } while (0)
#define SEAM(k) do { if (IN(k) && IN((k) + 1)) xcd_barrier(bar); } while (0)
#define P_IDX ((int*)(wsl + WS_SMALL + SM_IDX))
#define P_WTS ((float*)(wsl + WS_SMALL + SM_WTS))
#define P_RANK ((int*)(wsl + WS_SMALL + SM_RANK))
#define P_POS ((int*)(wsl + WS_SMALL + SM_POS))
#define P_ROWTOK ((int*)(wsl + WS_SMALL + SM_ROWTOK))
#define P_OFF ((int*)(wsl + WS_SMALL + SM_OFF))
#define P_TILE ((int*)(wsl + WS_SMALL + SM_TILE))
#define P_NT ((int*)(wsl + WS_SMALL + SM_NT))
#define P_LAM ((const float*)(wsl + WS_SMALL + SM_LAM))
#define P_CS ((const float*)(wsl + WS_SMALL + SM_CS))
#define P_BCNT ((int*)(wsl + WS_SMALL + SM_BCNT))
#define P_XB ((unsigned short*)(wsl + WS_XB))
#define P_Z ((unsigned short*)(wsl + WS_Z))
#define P_YA ((unsigned short*)(wsl + WS_YA))
#define P_YB ((unsigned short*)(wsl + WS_YB))
#define P_YC ((unsigned short*)(wsl + WS_YC))
#define P_G8 ((unsigned char*)(wsl + WS_MF))
#define P_MERGED ((unsigned short*)(wsl + WS_MERGED))
#define P_HID ((unsigned short*)(wsl + WS_HID))
#define P_YE ((unsigned short*)(wsl + WS_YE))
    unsigned char* wsl = ws; float* xf = args.out;
    const float alpha = 1.681792830507429f;
    const int gw = F.vcu * NWAVES + F.wave, NGW = F.G * NWAVES;

    if (IN(0)) { RELAUNDER(); p0_prologue(F, args); SEAM(0); }

    for (int l = 0; l < DEPTH; ++l) {
        const int pb = 1 + l * PH_PER_LAYER;

        if (IN(pb + 0)) {
            RELAUNDER();
            { pg8::SchedDense S{(const char*)P_XB, (const char*)(wsl + WS_W + (size_t)l * LW_STRIDE + LW_WIN), NTOK / 256, 12, F.G, (int)blockIdx.x, DM, 0};
              pg8::EpiInproj E{P_Z, P_CS};
              pg8::gemm_phase<pg8::EpiInproj, pg8::SchedDense, true>(F.lds + RING_OFF, DM, S, E); }
            RELAUNDER();
            { pg8::SchedDense S{(const char*)P_XB, (const char*)(wsl + WS_W + (size_t)l * LW_STRIDE + LW_WIN), NTOK / 256, 12, F.G, (int)blockIdx.x, DM, 14};
              pg8::EpiGate8 E{P_G8, 0, 0};
              pg8::gemm_phase<pg8::EpiGate8, pg8::SchedDense, true>(F.lds + RING_OFF, DM, S, E); }
            RELAUNDER();
            { pg8::SchedInprojHN S2{(const char*)P_XB, (const char*)(wsl + WS_W + (size_t)l * LW_STRIDE + LW_WIN), F.G, F.vcu, DM};
              pg8::EpiInprojHN E2{P_Z, 0, 0};
              pg8::gemm_phase_hn<pg8::EpiInprojHN, pg8::SchedInprojHN>(F.lds + RING_OFF, DM, S2, E2); }
            SEAM(pb + 0);
        }
        if (IN(pb + 1)) {
            RELAUNDER();
            const float lambda_init = 0.8f - 0.6f * expf(-0.3f * (float)l);
            const float lam = P_LAM[l] + lambda_init, oml = 1.0f - lambda_init;
            for (int p = F.vcu; p < 256; p += F.G) { const int bh = p >> 4, s = p & 15;
                att::attn_unit<1>(F.lds, P_Z, bh >> 2, bh & 3, s, nullptr, lam, oml, args.in[9] + l * 128, P_YC);
                att::attn_unit<1>(F.lds, P_Z, bh >> 2, bh & 3, 31 - s, nullptr, lam, oml, args.in[9] + l * 128, P_YC); }
            for (int u = F.vcu; u < 512; u += F.G) { const int bh = u >> 5, qb = u & 31;
                att::attn_unit<0>(F.lds, P_Z, bh >> 2, bh & 3, qb, args.in[2] + (size_t)l * 8 * RELN, 0.f, 0.f, nullptr, P_YA); }
            { int tl_ = threadIdx.x; asm volatile("" : "+v"(tl_)); for (int m = gw; m < NTOK / 8; m += NGW) att::mixb_rows8(P_Z, P_YB, m * 8, tl_ & 63); }
            SEAM(pb + 1);
        }
        if (IN(pb + 2)) {
            RELAUNDER();
            pg8::SchedBranchHN S{(const char*)P_YA, (const char*)(wsl + WS_W + (size_t)l * LW_STRIDE + LW_WBR), (size_t)(WS_YB - WS_YA), (size_t)MiB, F.G, F.vcu, 512};
            pg8::EpiBranchHN E{P_MERGED, P_G8};
            pg8::gemm_phase_hn<pg8::EpiBranchHN, pg8::SchedBranchHN>(F.lds + RING_OFF, 512, S, E);
            SEAM(pb + 2);
        }
        if (IN(pb + 3)) {
            RELAUNDER();
            pg8::SchedDense S{(const char*)P_MERGED, (const char*)(wsl + WS_W + (size_t)l * LW_STRIDE + LW_WOUT), NTOK / 256, DM / 256, F.G, (int)blockIdx.x, DM, 0};
            pg8::EpiWout E{P_XB, alpha, 0};
            pg8::gemm_phase<pg8::EpiWout, pg8::SchedDense, true>(F.lds + RING_OFF, DM, S, E);
            SEAM(pb + 3);
        }
        if (IN(pb + 4)) {
            RELAUNDER();
            for (int bb = blockIdx.x; bb < 256; bb += F.G) for (int i = bb * 512 + F.tid; i < MAXROWS; i += 256 * 512) P_ROWTOK[i] = 0;
            for (int tb = blockIdx.x; tb < 256; tb += F.G)
                ln1_router_block(F, tb, P_XB, args.in[14] + l * DM, args.in[15] + l * DM, (const unsigned short*)(wsl + WS_W + (size_t)l * LW_STRIDE + LW_RW), (const unsigned short*)(wsl + WS_W + (size_t)l * LW_STRIDE + LW_RW) + (size_t)NEXP * DM, args.in[17] + l * NEXP, P_IDX, P_WTS, P_RANK, P_BCNT);
            SEAM(pb + 4);
        }
        if (IN(pb + 5)) {
            RELAUNDER();
            for (int tb = blockIdx.x; tb < 256; tb += F.G) scatter_block(F, tb, P_BCNT, P_IDX, P_RANK, P_POS, P_ROWTOK, P_OFF, P_TILE, P_NT, tb == 0);
            SEAM(pb + 5);
        }
        if (IN(pb + 6)) {
            RELAUNDER();
            const int nu = group_setup(F, F.vcu, 2, P_TILE, P_NT, P_ROWTOK, true);
            pg8::SchedGroup<true> S{(const char*)P_XB, (const char*)(wsl + WS_W + (size_t)l * LW_STRIDE + LW_EGU), (const LAS int*)(F.lds + EXTRA_OFF), (const LAS int*)(F.lds + EXTRA_OFF + 256), nu, DM, 2};
            pg8::EpiGateUp E{P_HID};
            pg8::gemm_phase<pg8::EpiGateUp, pg8::SchedGroup<true>, true>(F.lds + RING_OFF, DM, S, E);
            SEAM(pb + 6);
        }
        if (IN(pb + 7)) {
            RELAUNDER();
            const int nu = group_setup(F, F.vcu, 4, P_TILE, P_NT, P_ROWTOK, false);
            pg8::SchedGroup<false> S{(const char*)P_HID, (const char*)(wsl + WS_W + (size_t)l * LW_STRIDE + LW_EDN), (const LAS int*)(F.lds + EXTRA_OFF), (const LAS int*)(F.lds + EXTRA_OFF + 256), nu, EDIM, 4};
            pg8::EpiStore8 E{(unsigned char*)P_YE, YE_SCALE, 0};
            pg8::gemm_phase<pg8::EpiStore8, pg8::SchedGroup<false>, true>(F.lds + RING_OFF, EDIM, S, E);
            SEAM(pb + 7);
        }
        if (IN(pb + 8)) {
            RELAUNDER();
            const int sbase = P_OFF[NEXP];
            for (int m = gw; m < NTOK / 2; m += NGW) { const int rows[2] = {m, m + NTOK / 2};
                combine_rows<2>(rows, F.lane, (l == DEPTH - 1) ? xf : (float*)nullptr, P_XB, P_YE, P_POS, P_WTS, sbase, args.in[22] + l * DM, args.in[23] + l * DM, alpha); }
            SEAM(pb + 8);
        }
    }
#undef IN
#undef SEAM
}
extern "C" void kernel_launch(void* const* d_in, const int* in_sizes, int n_in, void* d_out, int out_size, void* d_ws, size_t ws_size, hipStream_t stream) {
    static int grid = 0;
    if (grid == 0) {
        if (n_in != 24 || in_sizes[0] != NTOK * DM || out_size != NTOK * DM || ws_size < WS_MK_END) { fprintf(stderr, "kernel_launch: unexpected sizes n_in %d out %d ws %zu (need %zu); nothing launched\n", n_in, out_size, ws_size, (size_t)WS_MK_END); grid = -1; return; }
        int dev = 0, cus = 0, per_cu = 0;
        if (hipGetDevice(&dev) != hipSuccess || hipDeviceGetAttribute(&cus, hipDeviceAttributeMultiprocessorCount, dev) != hipSuccess) { fprintf(stderr, "kernel_launch: device query failed; nothing launched\n"); grid = -1; return; }
        if (hipFuncSetAttribute((const void*)mk_fwd, hipFuncAttributeMaxDynamicSharedMemorySize, LDS_BYTES) != hipSuccess) { fprintf(stderr, "kernel_launch: hipFuncSetAttribute failed; nothing launched\n"); grid = -1; return; }
        if (hipOccupancyMaxActiveBlocksPerMultiprocessor(&per_cu, (const void*)mk_fwd, NWAVES * 64, LDS_BYTES) != hipSuccess || per_cu < 1) fprintf(stderr, "kernel_launch: note: occupancy query reports %d workgroups per CU\n", per_cu);
        (void)hipGetLastError();
        grid = cus;
        if (grid != 256) fprintf(stderr, "kernel_launch: note: %d CUs (tuned for 256)\n", grid);
    }
    if (grid < 0) return;
    (void)hipMemsetAsync((char*)d_ws + WS_CTL, 0, 1 * MiB, stream);
    MkArgs a{};
    for (int i = 0; i < 24; ++i) a.in[i] = (const float*)d_in[i];
    a.out = (float*)d_out; a.ws = (unsigned char*)d_ws; a.ph_lo = 0; a.ph_hi = N_PHASES; a.li = 0; a.pad = 0;
    hipLaunchKernelGGL(mk_fwd, dim3(grid), dim3(NWAVES * 64), LDS_BYTES, stream, a);
}
```
